# Optimizing an MI355X kernel written in HIP

```python
import jax, jax.numpy as jnp
from jax import lax
import numpy as np

D_MODEL = 1024
BATCH = 2
SEQ = 16384
DEPTH = 4

N_MIXERS = 2
N_HEADS = 16
HEAD_DIM = D_MODEL // N_HEADS
Q_BLOCK = 128
SGU_CHUNK = 128
SGU_WIDTH = 2 * D_MODEL
SGU_GROUPS = 16
SGU_GROUP_DIM = SGU_WIDTH // SGU_GROUPS
FFN_HIDDEN = ((8 * D_MODEL // 3 + 255) // 256) * 256
N_ATTN_LAYERS = (DEPTH + 1) // 2
N_SGU_LAYERS = DEPTH // 2
NORM_EPS = 1e-6
LN_EPS = 1e-5

kernel_name = "fox_gmlp_interleaved_hybrid"


def rms_norm(x, w):
    xf = x.astype(jnp.float32)
    y = xf * lax.rsqrt(jnp.mean(xf * xf, axis=-1, keepdims=True) + NORM_EPS)
    return (y * w.astype(jnp.float32)).astype(x.dtype)


def forgetting_attention(h, w_in, b_f, w_out):
    B, S, _ = h.shape
    proj = h @ w_in
    q, k, v, f_logit = jnp.split(proj, [D_MODEL, 2 * D_MODEL, 3 * D_MODEL], axis=-1)
    q = q.reshape(B, S, N_HEADS, HEAD_DIM).transpose(0, 2, 1, 3)
    k = k.reshape(B, S, N_HEADS, HEAD_DIM).transpose(0, 2, 1, 3)
    v = v.reshape(B, S, N_HEADS, HEAD_DIM).transpose(0, 2, 1, 3)
    log_f = jax.nn.log_sigmoid((f_logit + b_f).astype(jnp.float32))
    c = jnp.cumsum(log_f, axis=1).transpose(0, 2, 1)
    n_blk = S // Q_BLOCK
    q_blk = q.reshape(B, N_HEADS, n_blk, Q_BLOCK, HEAD_DIM).transpose(2, 0, 1, 3, 4)
    c_blk = c.reshape(B, N_HEADS, n_blk, Q_BLOCK).transpose(2, 0, 1, 3)
    k_pos = jnp.arange(S)
    scale = HEAD_DIM ** -0.5

    def attend(args):
        qb, cb, start = args
        s = jnp.einsum('bhqd,bhkd->bhqk', qb, k, preferred_element_type=jnp.float32) * scale
        s = s + cb[..., :, None] - c[:, :, None, :]
        q_pos = start + jnp.arange(Q_BLOCK)
        s = jnp.where(k_pos[None, :] <= q_pos[:, None], s, -jnp.inf)
        p = jax.nn.softmax(s, axis=-1).astype(v.dtype)
        return jnp.einsum('bhqk,bhkd->bhqd', p, v)

    o = lax.map(attend, (q_blk, c_blk, jnp.arange(n_blk) * Q_BLOCK))
    o = o.transpose(1, 0, 3, 2, 4).reshape(B, S, D_MODEL)
    return o @ w_out


def spatial_gating_mixer(h, w_in, ln_g, ln_b, w_s, b_s, w_out):
    B, S, _ = h.shape
    z = jax.nn.gelu(h @ w_in, approximate=False)
    u, v = jnp.split(z, 2, axis=-1)
    vf = v.astype(jnp.float32)
    mu = jnp.mean(vf, axis=-1, keepdims=True)
    var = jnp.mean(jnp.square(vf - mu), axis=-1, keepdims=True)
    vn = ((vf - mu) * lax.rsqrt(var + LN_EPS) * ln_g.astype(jnp.float32)
          + ln_b.astype(jnp.float32)).astype(v.dtype)
    vc = vn.reshape(B, S // SGU_CHUNK, SGU_CHUNK, SGU_GROUPS, SGU_GROUP_DIM)
    w_causal = jnp.tril(w_s)
    mixed = jnp.einsum('gts,bcsgd->bctgd', w_causal, vc) + b_s.T[:, :, None]
    gated = u * mixed.reshape(B, S, SGU_WIDTH)
    return gated @ w_out


def swiglu_ffn(h, w_in, w_out):
    g, u = jnp.split(h @ w_in, 2, axis=-1)
    return (jax.nn.silu(g) * u) @ w_out


def setup_inputs(seed: int = 0) -> dict:
    key = jax.random.key(seed)
    ks = jax.random.split(key, 20)
    f32 = jnp.float32
    D = D_MODEL

    def nrm(k, shape, fan_in):
        return jax.random.normal(k, shape, f32) * (fan_in ** -0.5)

    def gain(k, shape):
        return 1.0 + 0.05 * jax.random.normal(k, shape, f32)

    x = jax.random.normal(ks[0], (BATCH, SEQ, D), f32)
    mixer_norm_w = gain(ks[1], (DEPTH, D))
    attn_w_in = nrm(ks[2], (N_ATTN_LAYERS, D, 3 * D + N_HEADS), D)
    attn_b_f = jax.random.uniform(ks[3], (N_ATTN_LAYERS, N_HEADS), f32, 1.0, 6.0)
    attn_w_out = nrm(ks[4], (N_ATTN_LAYERS, D, D), D)
    sgu_w_in = nrm(ks[5], (N_SGU_LAYERS, D, 2 * SGU_WIDTH), D)
    sgu_ln_g = gain(ks[6], (N_SGU_LAYERS, SGU_WIDTH))
    sgu_ln_b = 0.02 * jax.random.normal(ks[7], (N_SGU_LAYERS, SGU_WIDTH), f32)
    sgu_w_s = nrm(ks[8], (N_SGU_LAYERS, SGU_GROUPS, SGU_CHUNK, SGU_CHUNK), SGU_CHUNK)
    sgu_b_s = 1.0 + 0.1 * jax.random.normal(ks[9], (N_SGU_LAYERS, SGU_GROUPS, SGU_CHUNK), f32)
    sgu_w_out = nrm(ks[10], (N_SGU_LAYERS, SGU_WIDTH, D), SGU_WIDTH)
    ffn_norm_w = gain(ks[11], (DEPTH, D))
    ffn_w_in = nrm(ks[12], (DEPTH, D, 2 * FFN_HIDDEN), D)
    ffn_w_out = nrm(ks[13], (DEPTH, FFN_HIDDEN, D), FFN_HIDDEN)
    final_norm_w = gain(ks[14], (D,))
    return {"x": x, "mixer_norm_w": mixer_norm_w, "attn_w_in": attn_w_in,
            "attn_b_f": attn_b_f, "attn_w_out": attn_w_out, "sgu_w_in": sgu_w_in,
            "sgu_ln_g": sgu_ln_g, "sgu_ln_b": sgu_ln_b, "sgu_w_s": sgu_w_s,
            "sgu_b_s": sgu_b_s, "sgu_w_out": sgu_w_out, "ffn_norm_w": ffn_norm_w,
            "ffn_w_in": ffn_w_in, "ffn_w_out": ffn_w_out, "final_norm_w": final_norm_w}


def reference(x, mixer_norm_w, attn_w_in, attn_b_f, attn_w_out, sgu_w_in, sgu_ln_g,
              sgu_ln_b, sgu_w_s, sgu_b_s, sgu_w_out, ffn_norm_w, ffn_w_in, ffn_w_out,
              final_norm_w):
    for i in range(DEPTH):
        h = rms_norm(x, mixer_norm_w[i])
        j = i // N_MIXERS
        if i % N_MIXERS == 0:
            x = x + forgetting_attention(h, attn_w_in[j], attn_b_f[j], attn_w_out[j])
        else:
            x = x + spatial_gating_mixer(h, sgu_w_in[j], sgu_ln_g[j], sgu_ln_b[j],
                                         sgu_w_s[j], sgu_b_s[j], sgu_w_out[j])
        x = x + swiglu_ffn(rms_norm(x, ffn_norm_w[i]), ffn_w_in[i], ffn_w_out[i])
    return rms_norm(x, final_norm_w)
```

```cpp
#include <hip/hip_runtime.h>
#include <hip/hip_cooperative_groups.h>
#include <cstdio>
#include <cstdint>
namespace cg = cooperative_groups;
namespace pg8 {
#define PG8_LAS __attribute__((address_space(3)))
typedef unsigned short bf16_t;
typedef short bf16x8 __attribute__((ext_vector_type(8)));
typedef float f32x4 __attribute__((ext_vector_type(4)));
typedef unsigned u32x4 __attribute__((ext_vector_type(4)));
typedef unsigned u32x2 __attribute__((ext_vector_type(2)));
constexpr int BM = 256, BK = 64, HALF = 128, HTB = HALF * BK * 2  , STAGE_BYTES = 8 * HTB, NXCD = 8, WGM = 8;

__host__ __device__ __forceinline__ int lds_byte(int r, int c) { return (r >> 3) * 1024 + (r & 7) * 128 + ((((c >> 3) ^ (r >> 1)) & 7) << 4) + (c & 7) * 2; }
__host__ __device__ __forceinline__ void stage_rc(int b, int& R, int& C) { const int st = b >> 10, row = (b >> 7) & 7, pos = (b >> 4) & 7; R = st * 8 + row; C = ((pos ^ (R >> 1)) & 7) << 3; }
__host__ __device__ __forceinline__ int perm32(int rho) { const int n = rho >> 4, i = rho & 15; return 8 * (i >> 2) + 4 * n + (i & 3); }

struct Unit { int pm, pn, ord; };
struct Gemm { const bf16_t* A; const bf16_t* Bt; int M, N, K, lda; };

struct StaticOrder {
    int nM, nN, nwg, G, c;
    __host__ __device__ void init(int M, int N, int G_, int c_) { nM = M / BM; nN = N / BM; nwg = nM * nN; G = G_; c = c_; }
    __host__ __device__ bool next(int i, Unit& u) const {
        const long L = (long)i * G + c; if (L >= nwg) return false;
        int wgid = (int)L; { const int q = nwg / NXCD, r = nwg % NXCD, xcd = wgid % NXCD, off = wgid / NXCD; wgid = (xcd < r ? xcd * (q + 1) : r * (q + 1) + (xcd - r) * q) + off; }
        const int nig = WGM * nN, gid = wgid / nig, fm = gid * WGM, gsz = (nM - fm) < WGM ? (nM - fm) : WGM;
        u.pm = fm + ((wgid % nig) % gsz); u.pn = (wgid % nig) / gsz; u.ord = i; return true;
    }
    __device__ __forceinline__ void a_ready(const Unit&) const {}
    __device__ __forceinline__ void done(const Unit&) const {}
};

__device__ __forceinline__ unsigned cvt_pk_bf16(float lo, float hi) { unsigned r; asm volatile("v_cvt_pk_bf16_f32 %0, %1, %2" : "=v"(r) : "v"(lo), "v"(hi)); return r; }
typedef float f32x2 __attribute__((ext_vector_type(2)));
__device__ __forceinline__ f32x2 gelu_pk(f32x2 v) {
    const f32x2 av = __builtin_elementwise_abs(v), d = av * 0.2316418882f + 1.0f;
    f32x2 t; t.x = __builtin_amdgcn_rcpf(d.x); t.y = __builtin_amdgcn_rcpf(d.y);
    f32x2 q = t * 0.5307027145f + (-0.7265760135f); q = q * t + 0.7107068705f; q = q * t + (-0.142248368f); q = q * t + 0.127414796f; q = q * t;
    const f32x2 s = (v * v) * (-0.72134752044f);
    f32x2 e; e.x = __builtin_amdgcn_exp2f(s.x); e.y = __builtin_amdgcn_exp2f(s.y);
    const f32x2 m = v * (q * e), r = v - m;
    f32x2 o; o.x = v.x < 0.f ? m.x : r.x; o.y = v.y < 0.f ? m.y : r.y; return o;
}
__device__ __forceinline__ void st16_wt(void* p, u32x4 v) { asm volatile("global_store_dwordx4 %0, %1, off sc1\n\ts_nop 1" :: "v"(p), "v"(v) : "memory"); }
__device__ __forceinline__ float row_rstd(const float* ssq, int row) {
    const f32x4* p = (const f32x4*)(ssq + (size_t)row * 16);
    const f32x4 a = p[0], b = p[1], c = p[2], d = p[3];
    const f32x4 s = (a + b) + (c + d);
    return __builtin_amdgcn_rsqf(((s[0] + s[1]) + (s[2] + s[3])) * (1.0f / 1024.0f) + 1e-6f);
}
constexpr int RTAB_OFF = STAGE_BYTES;
template <class Sched> __device__ __forceinline__ void rstd_table(PG8_LAS unsigned char* lds, const float* ssq, const Sched& S) {
    PG8_LAS float* tab = (PG8_LAS float*)(lds + RTAB_OFF); int tid_ = threadIdx.x; asm volatile("" : "+v"(tid_));
    const int tid = tid_, half = tid >> 8, r = tid & 255; Unit u;
    int lastpm = -1; float val = 0.f;
    for (int i = half; S.next(i, u); i += 2) { if (u.pm != lastpm) { val = row_rstd(ssq, u.pm * BM + r); lastpm = u.pm; } tab[i * 256 + r] = val; }
    __syncthreads();
}
struct EpiQKV {
    static constexpr bool PERM = true, AFTER_DRAIN = false;
    bf16_t* O; size_t split_stride; const PG8_LAS float* rtab; float scale0; unsigned* kmax;
    __device__ __forceinline__ void operator()(const f32x4 (&acc)[2][2][4][2], const Unit& u, int wr, int wc, int fr, int fq) const {
        const int row0 = u.pm * BM + wr * 64 + fr; int colt = u.pn * BM; const int t = colt >> 10; bf16_t* base = O + (size_t)t * split_stride; colt &= 1023;
        const float sc = (t == 0) ? scale0 : 1.f; const int col0 = colt + wc * 32 + 8 * fq; float am[2] = {0.f, 0.f};
#pragma unroll
        for (int ai = 0; ai < 2; ++ai)
#pragma unroll
            for (int m = 0; m < 4; ++m) { const int row = row0 + ai * HALF + m * 16; const float rs = rtab[u.ord * 256 + ai * HALF + wr * 64 + m * 16 + fr] * sc; bf16_t* rowp = base + (size_t)row * 1024 + col0;
#pragma unroll
                for (int bj = 0; bj < 2; ++bj) { const f32x4 v0 = acc[ai][bj][m][0] * rs, v1 = acc[ai][bj][m][1] * rs;
                    u32x4 w; w.x = cvt_pk_bf16(v0[0], v0[1]); w.y = cvt_pk_bf16(v0[2], v0[3]); w.z = cvt_pk_bf16(v1[0], v1[1]); w.w = cvt_pk_bf16(v1[2], v1[3]);
                    st16_wt(rowp + bj * HALF, w);
                    if (t == 1) {
                        const float f0 = __builtin_bit_cast(float, w.x << 16), f1 = __builtin_bit_cast(float, w.x & 0xffff0000u), f2 = __builtin_bit_cast(float, w.y << 16), f3 = __builtin_bit_cast(float, w.y & 0xffff0000u);
                        const float f4 = __builtin_bit_cast(float, w.z << 16), f5 = __builtin_bit_cast(float, w.z & 0xffff0000u), f6 = __builtin_bit_cast(float, w.w << 16), f7 = __builtin_bit_cast(float, w.w & 0xffff0000u);
                        float s = ((f0 * f0 + f1 * f1) + (f2 * f2 + f3 * f3)) + ((f4 * f4 + f5 * f5) + (f6 * f6 + f7 * f7));
                        s += __shfl_xor(s, 16); s += __shfl_xor(s, 32); am[bj] = __builtin_fmaxf(am[bj], s); } } }
        if (t == 1) {
#pragma unroll
            for (int bj = 0; bj < 2; ++bj) { float v = am[bj];
#pragma unroll
                for (int o = 1; o < 64; o <<= 1) v = __builtin_fmaxf(v, __shfl_xor(v, o));
                if ((fr | fq) == 0) __hip_atomic_fetch_max(kmax + 2 * ((u.pm >> 6) * 16 + (colt >> 6) + 2 * bj + (wc >> 1)) + (wc & 1), __builtin_bit_cast(unsigned, v), __ATOMIC_RELAXED, __HIP_MEMORY_SCOPE_AGENT); } }
    }
};
struct EpiRes {
    static constexpr bool PERM = true, AFTER_DRAIN = false;
    bf16_t* XB; float* ssq;
    __device__ __forceinline__ void operator()(const f32x4 (&acc)[2][2][4][2], const Unit& u, int wr, int wc, int fr, int fq) const {
        const int col0 = u.pn * BM + wc * 32 + 8 * fq;
#pragma unroll
        for (int ai = 0; ai < 2; ++ai) {
            u32x4 xin[4][2];
#pragma unroll
            for (int m = 0; m < 4; ++m) { const size_t off = (size_t)(u.pm * BM + ai * HALF + wr * 64 + m * 16 + fr) * 1024 + col0;
#pragma unroll
                for (int bj = 0; bj < 2; ++bj) xin[m][bj] = *(const u32x4*)(XB + off + bj * HALF); }
#pragma unroll
            for (int m = 0; m < 4; ++m) { const int row = u.pm * BM + ai * HALF + wr * 64 + m * 16 + fr; const size_t off = (size_t)row * 1024 + col0; float q = 0.f;
#pragma unroll
                for (int bj = 0; bj < 2; ++bj) { const u32x4 xi = xin[m][bj]; const f32x4 a0 = acc[ai][bj][m][0], a1 = acc[ai][bj][m][1];
                    const float x0 = __builtin_bit_cast(float, xi.x << 16) + a0[0], x1 = __builtin_bit_cast(float, xi.x & 0xffff0000u) + a0[1], x2 = __builtin_bit_cast(float, xi.y << 16) + a0[2], x3 = __builtin_bit_cast(float, xi.y & 0xffff0000u) + a0[3];
                    const float x4 = __builtin_bit_cast(float, xi.z << 16) + a1[0], x5 = __builtin_bit_cast(float, xi.z & 0xffff0000u) + a1[1], x6 = __builtin_bit_cast(float, xi.w << 16) + a1[2], x7 = __builtin_bit_cast(float, xi.w & 0xffff0000u) + a1[3];
                    u32x4 w; w.x = cvt_pk_bf16(x0, x1); w.y = cvt_pk_bf16(x2, x3); w.z = cvt_pk_bf16(x4, x5); w.w = cvt_pk_bf16(x6, x7); st16_wt(XB + off + bj * HALF, w);
                    const float r0 = __builtin_bit_cast(float, w.x << 16), r1 = __builtin_bit_cast(float, w.x & 0xffff0000u), r2 = __builtin_bit_cast(float, w.y << 16), r3 = __builtin_bit_cast(float, w.y & 0xffff0000u);
                    const float r4 = __builtin_bit_cast(float, w.z << 16), r5 = __builtin_bit_cast(float, w.z & 0xffff0000u), r6 = __builtin_bit_cast(float, w.w << 16), r7 = __builtin_bit_cast(float, w.w & 0xffff0000u);
                    q += ((r0 * r0 + r1 * r1) + (r2 * r2 + r3 * r3)) + ((r4 * r4 + r5 * r5) + (r6 * r6 + r7 * r7)); }
                q += __shfl_xor(q, 16); q += __shfl_xor(q, 32);
                if (fq == 0) ssq[(size_t)row * 16 + u.pn * 4 + wc] = q; }
            asm volatile("" ::: "memory"); }
    }
};
struct EpiSwiGLU {
    static constexpr bool PERM = true, AFTER_DRAIN = false;
    bf16_t* H; const PG8_LAS float* rtab; int ldh;
    __device__ __forceinline__ void operator()(const f32x4 (&acc)[2][2][4][2], const Unit& u, int wr, int wc, int fr, int fq) const {
        const int row0 = u.pm * BM + wr * 64 + fr, col0 = u.pn * HALF + wc * 32 + 8 * fq;
#pragma unroll
        for (int ai = 0; ai < 2; ++ai)
#pragma unroll
            for (int m = 0; m < 4; ++m) { const int row = row0 + ai * HALF + m * 16; const float rs = rtab[u.ord * 256 + ai * HALF + wr * 64 + m * 16 + fr];
                float h[8];
#pragma unroll
                for (int n = 0; n < 2; ++n)
#pragma unroll
                    for (int e = 0; e < 4; ++e) { const float g = acc[ai][0][m][n][e] * rs, up = acc[ai][1][m][n][e] * rs;
                        h[n * 4 + e] = g * up * __builtin_amdgcn_rcpf(1.0f + __builtin_amdgcn_exp2f(g * -1.4426950408889634f)); }
                u32x4 w; w.x = cvt_pk_bf16(h[0], h[1]); w.y = cvt_pk_bf16(h[2], h[3]); w.z = cvt_pk_bf16(h[4], h[5]); w.w = cvt_pk_bf16(h[6], h[7]);
                st16_wt(H + (size_t)row * ldh + col0, w); }
    }
};
struct EpiGeluLN {
    static constexpr bool PERM = true, AFTER_DRAIN = false;
    bf16_t* Z; const PG8_LAS float* rtab; float* lnp;
    __device__ __forceinline__ void operator()(const f32x4 (&acc)[2][2][4][2], const Unit& u, int wr, int wc, int fr, int fq) const {
        const int row0 = u.pm * BM + wr * 64 + fr, col0 = u.pn * BM + wc * 32 + 8 * fq; const bool isv = u.pn >= 8;
#pragma unroll
        for (int ai = 0; ai < 2; ++ai)
#pragma unroll
            for (int m = 0; m < 4; ++m) { const int row = row0 + ai * HALF + m * 16; const float rs = rtab[u.ord * 256 + ai * HALF + wr * 64 + m * 16 + fr]; float s1 = 0.f, s2 = 0.f;
#pragma unroll
                for (int bj = 0; bj < 2; ++bj) { const f32x4 v0 = acc[ai][bj][m][0] * rs, v1 = acc[ai][bj][m][1] * rs;
                    const f32x2 a = gelu_pk((f32x2){v0[0], v0[1]}), b = gelu_pk((f32x2){v0[2], v0[3]}), c = gelu_pk((f32x2){v1[0], v1[1]}), d = gelu_pk((f32x2){v1[2], v1[3]});
                    s1 += ((a.x + a.y) + (b.x + b.y)) + ((c.x + c.y) + (d.x + d.y));
                    s2 += ((a.x * a.x + a.y * a.y) + (b.x * b.x + b.y * b.y)) + ((c.x * c.x + c.y * c.y) + (d.x * d.x + d.y * d.y));
                    u32x4 w; w.x = cvt_pk_bf16(a.x, a.y); w.y = cvt_pk_bf16(b.x, b.y); w.z = cvt_pk_bf16(c.x, c.y); w.w = cvt_pk_bf16(d.x, d.y);
                    st16_wt(Z + (size_t)row * 4096 + col0 + bj * HALF, w); }
                if (isv) { s1 += __shfl_xor(s1, 16); s1 += __shfl_xor(s1, 32); s2 += __shfl_xor(s2, 16); s2 += __shfl_xor(s2, 32);
                    if (fq == 0) *(f32x2*)(lnp + ((size_t)row * 32 + (u.pn - 8) * 4 + wc) * 2) = (f32x2){s1, s2}; } }
    }
};

template <class Epi, class Sched, bool ALIGN_EPI = false, bool SP2 = false>
__device__ __forceinline__ void gemm_phase(PG8_LAS unsigned char* lds, const Gemm g, const Sched& S, const Epi& E) {
    int tid_ = threadIdx.x; asm volatile("" : "+v"(tid_));
    const int tid = tid_, wid = __builtin_amdgcn_readfirstlane(tid >> 6), lane = tid & 63, wr = wid >> 2, wc = wid & 3, fr = lane & 15, fq = lane >> 4;
    const int K = g.K, nt = K / BK;
    unsigned voffA[2], voffB[2];
#pragma unroll
    for (int i = 0; i < 2; ++i) { int R, C; stage_rc(tid * 16 + i * 8192, R, C); const int Rb = Epi::PERM ? ((R & ~31) + perm32(R & 31)) : R;
        voffA[i] = (unsigned)(R * g.lda + C) * 2u; voffB[i] = (unsigned)(Rb * K + C) * 2u; }
    const size_t kstep = (size_t)(BK * 2);
    const size_t hstepA = (size_t)HALF * g.lda * 2, hstepB = (size_t)HALF * K * 2;
    const size_t tstepA = 2 * hstepA, tstepB = 2 * hstepB;
    const unsigned ldsw = (unsigned)wid * 1024u;
    const int aoffk[2] = {lds_byte(wr * 64 + fr, fq * 8), lds_byte(wr * 64 + fr, 32 + fq * 8)}, boffk[2] = {lds_byte(wc * 32 + fr, fq * 8), lds_byte(wc * 32 + fr, 32 + fq * 8)};
#define PG8_SA(b, h) (((b) * 2 + (h)) * HTB)
#define PG8_SB(b, h) ((4 + (b) * 2 + (h)) * HTB)
#define PG8_STAGE(bufoff, gbase, voff) do { _Pragma("unroll") for (int _i = 0; _i < 2; ++_i) \
        __builtin_amdgcn_global_load_lds((const unsigned*)((const char*)(gbase) + (voff)[_i]), (PG8_LAS unsigned*)(lds + (bufoff) + ldsw + _i * 8192), 16, 0, 0); } while (0)
#define PG8_LDA(dst, b, h) do { _Pragma("unroll") for (int m = 0; m < 4; ++m) _Pragma("unroll") for (int k = 0; k < 2; ++k) dst[m][k] = *(const PG8_LAS bf16x8*)(lds + PG8_SA(b, h) + aoffk[k] + m * 2048); } while (0)
#define PG8_LDB(dst, b, h) do { _Pragma("unroll") for (int n = 0; n < 2; ++n) _Pragma("unroll") for (int k = 0; k < 2; ++k) dst[n][k] = *(const PG8_LAS bf16x8*)(lds + PG8_SB(b, h) + boffk[k] + n * 2048); } while (0)
#define PG8_MMA(ai, bj, At, Bt) do { __builtin_amdgcn_s_setprio(1); _Pragma("unroll") for (int m = 0; m < 4; ++m) _Pragma("unroll") for (int n = 0; n < 2; ++n) _Pragma("unroll") for (int k = 0; k < 2; ++k) \
        acc[ai][bj][m][n] = __builtin_amdgcn_mfma_f32_16x16x32_bf16(Bt[n][k], At[m][k], acc[ai][bj][m][n], 0, 0, 0); __builtin_amdgcn_s_setprio(0); } while (0)
#define PG8_WAIT_V(n) asm volatile("s_waitcnt vmcnt(" #n ")" ::: "memory")
#define PG8_WAIT_L(n) asm volatile("s_waitcnt lgkmcnt(" #n ")" ::: "memory")
#define PG8_BAR __builtin_amdgcn_s_barrier()
#define PG8_SCHED __builtin_amdgcn_sched_barrier(0)
    Unit cur, nxt; int ui = 0;
    if (!S.next(0, cur)) return;
    f32x4 acc[2][2][4][2];
#pragma unroll
    for (int a = 0; a < 2; ++a)
#pragma unroll
        for (int b = 0; b < 2; ++b)
#pragma unroll
            for (int m = 0; m < 4; ++m)
#pragma unroll
                for (int n = 0; n < 2; ++n) acc[a][b][m][n] = (f32x4){0.f, 0.f, 0.f, 0.f};
    bf16x8 At[4][2], B0[2][2], B1[2][2];
    const char* cA = (const char*)g.A + (size_t)cur.pm * tstepA; const char* cB = (const char*)g.Bt + (size_t)cur.pn * tstepB;
    S.a_ready(cur);
    if constexpr (SP2) {
        PG8_STAGE(PG8_SB(0, 0), cB, voffB); PG8_STAGE(PG8_SB(0, 1), cB + hstepB, voffB); PG8_STAGE(PG8_SA(0, 0), cA, voffA); PG8_STAGE(PG8_SA(0, 1), cA + hstepA, voffA);
        if (wr == 1) PG8_BAR;
        PG8_WAIT_V(2); PG8_BAR;
        PG8_STAGE(PG8_SB(1, 0), cB + kstep, voffB); PG8_STAGE(PG8_SA(1, 0), cA + kstep, voffA); PG8_STAGE(PG8_SB(1, 1), cB + hstepB + kstep, voffB);
        PG8_WAIT_V(6); PG8_BAR;
    } else {
        PG8_STAGE(PG8_SB(0, 0), cB, voffB); PG8_STAGE(PG8_SA(0, 0), cA, voffA); PG8_STAGE(PG8_SB(0, 1), cB + hstepB, voffB); PG8_STAGE(PG8_SA(0, 1), cA + hstepA, voffA);
        if (wr == 1) PG8_BAR;
        PG8_WAIT_V(4); PG8_BAR;
        PG8_STAGE(PG8_SB(1, 0), cB + kstep, voffB); PG8_STAGE(PG8_SA(1, 0), cA + kstep, voffA); PG8_STAGE(PG8_SB(1, 1), cB + hstepB + kstep, voffB);
        PG8_WAIT_V(6); PG8_BAR;
    }
    for (;;) {
        const bool has_next = S.next(ui + 1, nxt);
        const char* nA = has_next ? (const char*)g.A + (size_t)nxt.pm * tstepA : cA; const char* nB = has_next ? (const char*)g.Bt + (size_t)nxt.pn * tstepB : cB;
        for (int t = 0; t < nt; t += 2) {
            const bool last = (t == nt - 2);
            const char* a1 = cA + (size_t)(t + 1) * kstep;
            const char* a2 = last ? nA : cA + (size_t)(t + 2) * kstep; const char* b2 = last ? nB : cB + (size_t)(t + 2) * kstep;
            const char* a3 = a2 + kstep; const char* b3 = b2 + kstep;
            if (last && has_next) S.a_ready(nxt);
            if constexpr (SP2) {
            PG8_LDB(B0, 0, 0); PG8_LDB(B1, 0, 1); PG8_SCHED; PG8_LDA(At, 0, 0); PG8_STAGE(PG8_SA(1, 1), a1 + hstepA, voffA);
            PG8_WAIT_V(8); PG8_WAIT_L(0); PG8_BAR; PG8_MMA(0, 0, At, B0); PG8_MMA(0, 1, At, B1); PG8_BAR; PG8_SCHED;
            PG8_LDA(At, 0, 1); PG8_STAGE(PG8_SB(0, 0), b2, voffB); PG8_STAGE(PG8_SB(0, 1), b2 + hstepB, voffB); PG8_STAGE(PG8_SA(0, 0), a2, voffA);
            PG8_WAIT_V(8); PG8_WAIT_L(0); PG8_BAR; PG8_MMA(1, 0, At, B0); PG8_MMA(1, 1, At, B1); PG8_BAR; PG8_SCHED;
            PG8_LDB(B0, 1, 0); PG8_LDB(B1, 1, 1); PG8_SCHED; PG8_LDA(At, 1, 0); PG8_STAGE(PG8_SA(0, 1), a2 + hstepA, voffA);
            PG8_WAIT_V(8); PG8_WAIT_L(0); PG8_BAR; PG8_MMA(0, 0, At, B0); PG8_MMA(0, 1, At, B1); PG8_BAR; PG8_SCHED;
            PG8_LDA(At, 1, 1); PG8_STAGE(PG8_SB(1, 0), b3, voffB); PG8_STAGE(PG8_SB(1, 1), b3 + hstepB, voffB); PG8_STAGE(PG8_SA(1, 0), a3, voffA);
            PG8_WAIT_V(8); PG8_WAIT_L(0); PG8_BAR; PG8_MMA(1, 0, At, B0); PG8_MMA(1, 1, At, B1); PG8_BAR; PG8_SCHED;
            } else {
            PG8_LDB(B0, 0, 0); PG8_SCHED; PG8_LDA(At, 0, 0); PG8_STAGE(PG8_SA(1, 1), a1 + hstepA, voffA);
            PG8_WAIT_L(8); PG8_BAR; PG8_WAIT_L(0); PG8_MMA(0, 0, At, B0); PG8_BAR; PG8_SCHED;
            PG8_LDB(B1, 0, 1); PG8_STAGE(PG8_SB(0, 0), b2, voffB);
            PG8_BAR; PG8_WAIT_L(0); PG8_MMA(0, 1, At, B1); PG8_BAR;
            PG8_LDA(At, 0, 1); PG8_STAGE(PG8_SA(0, 0), a2, voffA);
            PG8_BAR; PG8_WAIT_L(0); PG8_MMA(1, 0, At, B0); PG8_BAR; PG8_SCHED;
            PG8_STAGE(PG8_SB(0, 1), b2 + hstepB, voffB);
            PG8_WAIT_V(6); PG8_BAR; PG8_MMA(1, 1, At, B1); PG8_BAR;
            PG8_LDB(B0, 1, 0); PG8_SCHED; PG8_LDA(At, 1, 0); PG8_STAGE(PG8_SA(0, 1), a2 + hstepA, voffA);
            PG8_WAIT_L(8); PG8_BAR; PG8_WAIT_L(0); PG8_MMA(0, 0, At, B0); PG8_BAR; PG8_SCHED;
            PG8_LDB(B1, 1, 1); PG8_STAGE(PG8_SB(1, 0), b3, voffB);
            PG8_BAR; PG8_WAIT_L(0); PG8_MMA(0, 1, At, B1); PG8_BAR;
            PG8_LDA(At, 1, 1); PG8_STAGE(PG8_SA(1, 0), a3, voffA);
            PG8_BAR; PG8_WAIT_L(0); PG8_MMA(1, 0, At, B0); PG8_BAR; PG8_SCHED;
            PG8_STAGE(PG8_SB(1, 1), b3 + hstepB, voffB);
            PG8_WAIT_V(6); PG8_BAR; PG8_MMA(1, 1, At, B1); PG8_BAR;
            }
        }
        if constexpr (ALIGN_EPI) { if (wr == 0) PG8_BAR; }
        if constexpr (!Epi::AFTER_DRAIN) { E(acc, cur, wr, wc, fr, fq); S.done(cur); }
        if (!has_next) break;
#pragma unroll
        for (int a = 0; a < 2; ++a)
#pragma unroll
            for (int b = 0; b < 2; ++b)
#pragma unroll
                for (int m = 0; m < 4; ++m)
#pragma unroll
                    for (int n = 0; n < 2; ++n) acc[a][b][m][n] = (f32x4){0.f, 0.f, 0.f, 0.f};
        cur = nxt; cA = nA; cB = nB; ++ui;
        if constexpr (ALIGN_EPI) { if (wr == 1) PG8_BAR; }
    }
    PG8_WAIT_V(0);
    if constexpr (!ALIGN_EPI) { if (wr == 0) PG8_BAR; }
    PG8_BAR;
    if constexpr (Epi::AFTER_DRAIN) { E.fused(acc, cur, wr, wc, fr, fq, lds, wid, lane); S.done(cur); }
#undef PG8_SA
#undef PG8_SB
#undef PG8_STAGE
#undef PG8_LDA
#undef PG8_LDB
#undef PG8_MMA
#undef PG8_WAIT_V
#undef PG8_WAIT_L
#undef PG8_BAR
#undef PG8_SCHED
}
}
#include <hip/hip_bf16.h>
#include <cmath>
namespace attn_body {
using bf16=__hip_bfloat16;
using bf16x8=__attribute__((ext_vector_type(8)))short;
using s16x4=__attribute__((ext_vector_type(4)))short;
using f32x16=__attribute__((ext_vector_type(16)))float;
using u32x4=__attribute__((ext_vector_type(4)))unsigned;
using f32x4b=__attribute__((ext_vector_type(4)))float;
constexpr int BATCH=2,NHEAD=16,SEQ=16384,D=64,DM=NHEAD*D;
constexpr int NW=8,QBLK=32,QB=QBLK*NW,KVBLK=64,NQB=SEQ/QB;
constexpr int ATTN_PITCH=DM, ATTN_UNIT_ROWS=QB;
__device__ __forceinline__ int crow(int r,int hi){return (r&3)+8*(r>>2)+4*hi;}
#define SBAR() __builtin_amdgcn_sched_barrier(0)
__device__ __forceinline__ void cmask(f32x16&p0,f32x16&p1,int jb,int qrel,int hi){
  const float NEG=-INFINITY; int kb=64*jb+4*hi;
  #pragma unroll
  for(int r=0;r<16;++r){int kv=kb+(r&3)+8*(r>>2); if(kv>qrel)p0[r]=NEG; if(kv+32>qrel)p1[r]=NEG;}
}

constexpr int NSLOT=3, SLOTB=8192;
constexpr int LDS_K=0, LDS_V=NSLOT*SLOTB, LDS_WS=2*NSLOT*SLOTB, LDS_OST=LDS_WS+NW*64*4, LDS_KB=LDS_OST+NW*4096, LDS_BYTES=LDS_KB+SEQ*4+64;
constexpr float C2=0.125f*1.4426950408889634f;
__device__ __forceinline__ void glds16(const void*gsrc,unsigned lds_dst){unsigned keep;
  asm volatile("s_mov_b32 %0, m0\n\ts_mov_b32 m0, %2\n\ts_nop 0\n\tglobal_load_lds_dwordx4 %1, off\n\ts_mov_b32 m0, %0":"=&s"(keep):"v"(gsrc),"s"(lds_dst):"memory");}
__device__ __forceinline__ float max3f(float a,float b,float c){float r;asm("v_max3_f32 %0, %1, %2, %3":"=v"(r):"v"(a),"v"(b),"v"(c));return r;}
__device__ __forceinline__ float max2f(float a,float b){float r;asm("v_max_f32_e32 %0, %1, %2":"=v"(r):"v"(a),"v"(b));return r;}
__device__ __forceinline__ float fadd_s(float a,float b){float r;asm("v_add_f32_e32 %0, %1, %2":"=v"(r):"v"(a),"v"(b));return r;}
__device__ __forceinline__ float fsub_s(float a,float b){float r;asm("v_sub_f32_e32 %0, %1, %2":"=v"(r):"v"(a),"v"(b));return r;}
typedef float f32x2_t __attribute__((ext_vector_type(2))); typedef __bf16 bf16x2_t __attribute__((ext_vector_type(2)));
__device__ __forceinline__ unsigned cvtpk_s(float lo,float hi){f32x2_t v={lo,hi};bf16x2_t b=__builtin_convertvector(v,bf16x2_t);return __builtin_bit_cast(unsigned,b);}
#define WAIT_BAR(N) asm volatile("s_waitcnt vmcnt(" #N ") lgkmcnt(0)\n\ts_barrier":::"memory")

typedef short s16x4b __attribute__((ext_vector_type(4))); typedef unsigned u32x2b __attribute__((ext_vector_type(2)));
#define BIAS_MFMA(a0_,d1_,qm_) __builtin_amdgcn_mfma_f32_32x32x8bf16_1k(__builtin_bit_cast(s16x4b,(u32x2b){(a0_),(d1_)}),__builtin_bit_cast(s16x4b,(qm_)),f32x16{},0,0,0)
__device__ __forceinline__ void qkt(f32x16&p0,f32x16&p1,const char*Kslot,const bf16x8*qr,unsigned ka0,unsigned ka1,unsigned kd1,u32x2b qm,int r32,int hi){
  p0=BIAS_MFMA(ka0,kd1,qm); p1=BIAS_MFMA(ka1,kd1,qm);
  const char*kb=Kslot+hi*1024+r32*16;
  #pragma unroll
  for(int d0=0;d0<4;++d0){
    const bf16x8 b0=*reinterpret_cast<const bf16x8*>(kb+d0*2048);
    const bf16x8 b1=*reinterpret_cast<const bf16x8*>(kb+d0*2048+512);
    {p0=__builtin_amdgcn_mfma_f32_32x32x16_bf16(b0,qr[d0],p0,0,0,0);p1=__builtin_amdgcn_mfma_f32_32x32x16_bf16(b1,qr[d0],p1,0,0,0);}}
}
typedef __attribute__((address_space(3))) const char* lds_cptr;
typedef short v4i16_t __attribute__((ext_vector_type(4)));
__device__ __forceinline__ void kload8(bf16x8*kf,lds_cptr kp){
  kf[0]=*(const __attribute__((address_space(3))) bf16x8*)(kp);      kf[1]=*(const __attribute__((address_space(3))) bf16x8*)(kp+512);
  kf[2]=*(const __attribute__((address_space(3))) bf16x8*)(kp+2048); kf[3]=*(const __attribute__((address_space(3))) bf16x8*)(kp+2560);
  kf[4]=*(const __attribute__((address_space(3))) bf16x8*)(kp+4096); kf[5]=*(const __attribute__((address_space(3))) bf16x8*)(kp+4608);
  kf[6]=*(const __attribute__((address_space(3))) bf16x8*)(kp+6144); kf[7]=*(const __attribute__((address_space(3))) bf16x8*)(kp+6656);
}
__device__ __forceinline__ void kload2(bf16x8*kf,lds_cptr kp,int j){ kf[2*j]=*(const __attribute__((address_space(3))) bf16x8*)(kp+j*2048); kf[2*j+1]=*(const __attribute__((address_space(3))) bf16x8*)(kp+j*2048+512); }
__device__ __forceinline__ s16x4 vtr(lds_cptr p){ return __builtin_bit_cast(s16x4,__builtin_amdgcn_ds_read_tr16_b64_v4i16((__attribute__((address_space(3))) v4i16_t*)p)); }
__device__ __forceinline__ float rowmax(const f32x16&p0,const f32x16&p1){
  float a=max3f(p0[0],p0[1],p1[0]),b=max3f(p0[2],p0[3],p1[1]);a=max3f(a,p1[2],p1[3]);
  #pragma unroll
  for(int r=4;r<16;r+=4){a=max3f(a,p0[r],p0[r+1]);b=max3f(b,p0[r+2],p0[r+3]);a=max3f(a,p1[r],p1[r+1]);b=max3f(b,p1[r+2],p1[r+3]);}
  const float m=max2f(a,b);
  auto rr=__builtin_amdgcn_permlane32_swap(__float_as_uint(m),__float_as_uint(m),false,false);
  return max2f(__uint_as_float(rr[0]),__uint_as_float(rr[1]));
}
__device__ __forceinline__ void pv(f32x16*o,int vb,bf16x8 pa0,bf16x8 pa1,bf16x8 pa2,bf16x8 pa3){
  #pragma unroll
  for(int d0=0;d0<2;++d0){s16x4 lo[4],hi[4];
    #pragma unroll
    for(int ks=0;ks<4;++ks){
      asm volatile("ds_read_b64_tr_b16 %0,%1 offset:%c2":"=&v"(lo[ks]):"v"(vb),"i"(d0*4096+ks*1024):"memory");
      asm volatile("ds_read_b64_tr_b16 %0,%1 offset:%c2":"=&v"(hi[ks]):"v"(vb),"i"(d0*4096+ks*1024+512):"memory");}
    asm volatile("s_waitcnt lgkmcnt(0)":::"memory");SBAR();
    #define PK(k) (bf16x8){lo[k][0],lo[k][1],lo[k][2],lo[k][3],hi[k][0],hi[k][1],hi[k][2],hi[k][3]}
    o[d0]=__builtin_amdgcn_mfma_f32_32x32x16_bf16(pa0,PK(0),o[d0],0,0,0);
    o[d0]=__builtin_amdgcn_mfma_f32_32x32x16_bf16(pa1,PK(1),o[d0],0,0,0);
    o[d0]=__builtin_amdgcn_mfma_f32_32x32x16_bf16(pa2,PK(2),o[d0],0,0,0);
    o[d0]=__builtin_amdgcn_mfma_f32_32x32x16_bf16(pa3,PK(3),o[d0],0,0,0);
    #undef PK
  }
}

#ifndef ATTN_STORE16
#define ATTN_STORE16(p,v) (*(u32x4*)(p)=(v))
#endif
template<int THRL> __device__ __forceinline__ void attn_unit(int b,int h,int qb,const bf16*Q,const bf16*__restrict__ K,const bf16*__restrict__ V,bf16*O,const float*__restrict__ CB,const float kmax,char*shm){
  int tid_=threadIdx.x; asm volatile("":"+v"(tid_)); const int tid=tid_,lane=tid&63,r32=lane&31,hi=lane>>5; const int wid=__builtin_amdgcn_readfirstlane(tid>>6);
  const long rowbase=(long)b*SEQ; const int q0=qb*QB;
  const bf16*Qw=Q+(rowbase+q0+wid*QBLK)*DM+h*D;
  const lds_cptr shm3=(lds_cptr)shm;
  const float*CBh=CB+((long)b*NHEAD+h)*SEQ;
  bf16x8 qr[4];
  #pragma unroll
  for(int d0=0;d0<4;++d0)qr[d0]=*reinterpret_cast<const bf16x8*>(&Qw[(long)r32*DM+d0*16+hi*8]);
  const int NTfull=(q0+QB)/KVBLK;
  const float cref=CBh[q0];
  const int t0c=2*(tid+1); const bool cand=t0c<=NTfull-4; const float cvc=cand?CBh[64*t0c-1]:0.f;
  const float mrow=cref-CBh[q0+wid*QBLK+r32];
  __attribute__((address_space(3))) unsigned*t0slot=(__attribute__((address_space(3))) unsigned*)(shm3+LDS_KB+SEQ*4);
  { float qa=0.f;
    #pragma unroll
    for(int d0=0;d0<4;++d0)
      #pragma unroll
      for(int e=0;e<8;++e){const float qv=__uint_as_float((unsigned)(unsigned short)qr[d0][e]<<16);qa+=qv*qv;}
    qa+=__shfl_xor(qa,32);
    #pragma unroll
    for(int of=1;of<32;of<<=1)qa=__builtin_fmaxf(qa,__shfl_xor(qa,of));
    if(lane==0)*(__attribute__((address_space(3))) float*)(shm3+LDS_WS+wid*256)=qa;
    if(tid==0)*t0slot=0u;
    asm volatile("s_waitcnt lgkmcnt(0)\n\ts_barrier":::"memory");
    float qmax=0.f;
    #pragma unroll
    for(int w=0;w<NW;++w)qmax=__builtin_fmaxf(qmax,*(const __attribute__((address_space(3))) float*)(shm3+LDS_WS+w*256));
    const float qkb=__builtin_sqrtf(qmax)*kmax*1.0005f+1.0f;
    const bool pass=cand&&((cref-cvc)+qkb<-127.0f);
    const unsigned long long bal=__ballot(pass);
    if(lane==0&&bal!=0ull)__hip_atomic_fetch_max(t0slot,(unsigned)(2*(wid*64+(63-__builtin_clzll(bal))+1)),__ATOMIC_RELAXED,__HIP_MEMORY_SCOPE_WORKGROUP);
    asm volatile("s_waitcnt lgkmcnt(0)\n\ts_barrier":::"memory"); }
  const int t0=__builtin_amdgcn_readfirstlane((int)*t0slot);
  const int q0s=q0-t0*KVBLK;
  const bf16*Kh=K+(rowbase+t0*KVBLK)*DM+h*D,*Vh=V+(rowbase+t0*KVBLK)*DM+h*D;
  const unsigned lds0=(unsigned)(uintptr_t)shm;
  float*wsf=(float*)(shm+LDS_WS)+wid*64;
  const bf16*ksrc=Kh+(long)lane*DM+wid*8;
  const bf16*vsrc=Vh+(long)(16*(wid&3)+(lane>>2))*DM+(wid>>2)*32+(lane&3)*8;
  const unsigned kdst=lds0+LDS_K+wid*1024, vdst=lds0+LDS_V+wid*1024;
  #define DMA_K(t,slot) glds16(ksrc+(long)(t)*KVBLK*DM,(unsigned)__builtin_amdgcn_readfirstlane(kdst+(slot)))
  #define DMA_V(t,slot) glds16(vsrc+(long)(t)*KVBLK*DM,(unsigned)__builtin_amdgcn_readfirstlane(vdst+(slot)))
  const int vb0=(int)(lds0+LDS_V)+((lane>>4)&1)*32+(lane&3)*8+(4*hi+((lane&15)>>2))*64;
  const char*Kbase=shm+LDS_K; bf16x8 kf[8];
  const lds_cptr kp0=shm3+LDS_K+hi*1024+r32*16; const lds_cptr vp0=shm3+LDS_V+((lane>>4)&1)*32+(lane&3)*8+(4*hi+((lane&15)>>2))*64;
  const int NT=(q0s+QB)/KVBLK;
  const lds_cptr kbp=shm3+LDS_KB+r32*4; constexpr unsigned kd1=0x0000BF80u;
  #define KBLD(t,A0,A1) do{ const unsigned x0_=*(const __attribute__((address_space(3))) unsigned*)(kbp+(t)*256), x1_=*(const __attribute__((address_space(3))) unsigned*)(kbp+(t)*256+128); A0=hi?0xBF80BF80u:x0_; A1=hi?0xBF80BF80u:x1_; }while(0)
  u32x2b qm; qm.x=hi?0u:0x3F803F80u; qm.y=0u;
  #define QMSET() do{ if(hi){ const unsigned b0_=__float_as_uint(mhat)&0xffff0000u; const float r1_=mhat-__uint_as_float(b0_); const unsigned b1_=__float_as_uint(r1_)&0xffff0000u; const float r2_=r1_-__uint_as_float(b1_); qm.x=(b0_>>16)|b1_; qm.y=__float_as_uint(r2_)>>16; } }while(0)
  unsigned ka0,ka1;
  DMA_K(0,0);DMA_V(0,0);DMA_K(1,SLOTB);
  { const float*CBs=CBh+t0*KVBLK; __attribute__((address_space(3))) unsigned*kbl=(__attribute__((address_space(3))) unsigned*)(shm3+LDS_KB);
    for(int s0=tid*4;s0<q0s+QB;s0+=NW*64*4){ const f32x4b cv=*(const f32x4b*)(CBs+s0); u32x4 w;
      _Pragma("unroll") for(int e=0;e<4;++e){ const float v=cref-cv[e]; const unsigned vb=__float_as_uint(v)&0xffff0000u; const float r=v-__uint_as_float(vb); w[e]=(vb>>16)|(__float_as_uint(r)&0xffff0000u); }
      *(__attribute__((address_space(3))) u32x4*)(kbl+s0)=w; }
 }
  float mhat=mrow,l_reg=0.f; QMSET();f32x16 o[2];o[0]=f32x16{};o[1]=f32x16{};
  const int qrel=wid*QBLK+r32;
  #define CMASK(P0,P1,t) do{int jb_=(t)-(NT-4); if(jb_>=0)cmask(P0,P1,jb_,qrel,hi);}while(0)
  bool resc=false;
  #define START(P0,P1) do{ const float rm=rowmax(P0,P1); resc=false; \
    { const float dl=__builtin_fmaxf(rm,0.f); mhat=fadd_s(mhat,dl); \
      _Pragma("unroll") for(int r=0;r<16;++r){P0[r]=fsub_s(P0[r],dl);P1[r]=fsub_s(P1[r],dl);} \
      QMSET(); } \
    _Pragma("unroll") for(int r=0;r<16;++r)P0[r]=__builtin_amdgcn_exp2f(P0[r]); }while(0)
  #define RESC() do{ if(resc){ asm volatile("s_waitcnt lgkmcnt(0)":::"memory"); \
      _Pragma("unroll") for(int d_=0;d_<2;++d_) _Pragma("unroll") for(int r=0;r<16;++r)o[d_][r]*=wsf[crow(r,hi)]; } }while(0)
  f32x16 pA0,pA1,pB0,pB1;
  int sl_prev=0,sl_cur=0,sl_next=SLOTB;
  #define ROT() do{sl_prev=sl_cur;sl_cur=sl_next;sl_next=(sl_next==(NSLOT-1)*SLOTB)?0:sl_next+SLOTB;}while(0)
  DMA_K(2,2*SLOTB);
  WAIT_BAR(3); KBLD(0,ka0,ka1);
  qkt(pA0,pA1,Kbase,qr,ka0,ka1,kd1,qm,r32,hi);asm volatile("s_nop 15\n\ts_nop 7":"+v"(pA0),"+v"(pA1));CMASK(pA0,pA1,0);
  START(pA0,pA1);
  _Pragma("unroll") for(int r=0;r<16;++r)pA1[r]=__builtin_amdgcn_exp2f(pA1[r]);
  WAIT_BAR(0);
  DMA_K(3,0);DMA_V(1,SLOTB);
  ROT();
  kload8(kf,kp0+sl_cur); KBLD(1,ka0,ka1);
  WAIT_BAR(2);
  s16x4 vlo[8],vhi[8]; u32x4 pw0,pw1,pw2,pw3;
  #define PKW(P,B) cvtpk_s(P[B],P[B+1])
  #define PAF(k) __builtin_bit_cast(bf16x8,pw##k)
  #define VFR(i) (bf16x8){vlo[i][0],vlo[i][1],vlo[i][2],vlo[i][3],vhi[i][0],vhi[i][1],vhi[i][2],vhi[i][3]}
  #define PIN(x) asm volatile("":"+v"(x))
  #define MX3(a,b,c) __builtin_fmaxf(__builtin_fmaxf((a),(b)),(c))
  #define GAPA(MF,A0,A1,A2,A3,W0,W1,PW) do{ MF; sacc+=A0; sacc+=A1; sacc+=A2; sacc+=A3; PIN(sacc); W0; W1; PIN(PW); SBAR(); }while(0)
  #define EX(v) __builtin_amdgcn_exp2f(v)
  #define GAPB(MF,X,B) do{ MF; X[B]=EX(X[B]); X[B+1]=EX(X[B+1]); X[B+2]=EX(X[B+2]); X[B+3]=EX(X[B+3]); PIN(X); SBAR(); }while(0)
  #define VRD(i) do{ vlo[i]=vtr(vp_+(((i)>>2)*4096+((i)&3)*1024)); vhi[i]=vtr(vp_+(((i)>>2)*4096+((i)&3)*1024+512)); }while(0)
  #define KRD(G,j) do{ if(G){ kload2(kf,kp0+sl_next,j); SBAR(); } }while(0)
  #define STEP(C0,C1,P0,P1,t,GK,GV,GL) do{ SBAR(); \
    const lds_cptr vp_=vp0+sl_prev; \
    VRD(0); SBAR(); float sacc=(P0[0]+P0[1]); \
    C0=BIAS_MFMA(ka0,kd1,qm); C1=BIAS_MFMA(ka1,kd1,qm); \
    GAPA(C0=__builtin_amdgcn_mfma_f32_32x32x16_bf16(kf[0],qr[0],C0,0,0,0), P0[2],P0[3],P0[4],P0[5],     pw0[0]=PKW(P0,0), pw0[1]=PKW(P0,2), pw0); \
    VRD(4); SBAR(); GAPA(C1=__builtin_amdgcn_mfma_f32_32x32x16_bf16(kf[1],qr[0],C1,0,0,0), P0[6],P0[7],P0[8],P0[9],     pw0[2]=PKW(P0,4), pw0[3]=PKW(P0,6), pw0); \
    VRD(1); SBAR(); GAPA(C0=__builtin_amdgcn_mfma_f32_32x32x16_bf16(kf[2],qr[1],C0,0,0,0),   P0[10],P0[11],P0[12],P0[13], pw1[0]=PKW(P0,8), pw1[1]=PKW(P0,10), pw1); \
    VRD(5); SBAR(); GAPA(C1=__builtin_amdgcn_mfma_f32_32x32x16_bf16(kf[3],qr[1],C1,0,0,0),   P0[14],P0[15],P1[0],P1[1],   pw1[2]=PKW(P0,12),pw1[3]=PKW(P0,14), pw1); \
    VRD(2); SBAR(); GAPA(C0=__builtin_amdgcn_mfma_f32_32x32x16_bf16(kf[4],qr[2],C0,0,0,0),   P1[2],P1[3],P1[4],P1[5],     pw2[0]=PKW(P1,0), pw2[1]=PKW(P1,2), pw2); \
    VRD(6); SBAR(); GAPA(C1=__builtin_amdgcn_mfma_f32_32x32x16_bf16(kf[5],qr[2],C1,0,0,0),   P1[6],P1[7],P1[8],P1[9],     pw2[2]=PKW(P1,4), pw2[3]=PKW(P1,6), pw2); \
    VRD(3); SBAR(); GAPA(C0=__builtin_amdgcn_mfma_f32_32x32x16_bf16(kf[6],qr[3],C0,0,0,0),   P1[10],P1[11],P1[12],P1[13], pw3[0]=PKW(P1,8), pw3[1]=PKW(P1,10), pw3); \
    VRD(7); SBAR(); GAPA(C1=__builtin_amdgcn_mfma_f32_32x32x16_bf16(kf[7],qr[3],C1,0,0,0),   P1[14],P1[15],0.f,0.f,       pw3[2]=PKW(P1,12),pw3[3]=PKW(P1,14), pw3); \
    l_reg+=sacc; \
    if(GK){DMA_K((t)+3,sl_cur);} if(GV){DMA_V((t)+1,sl_next);} \
    CMASK(C0,C1,t); \
    { float a=MX3(C0[0],C0[1],C1[0]),b=MX3(C0[2],C0[3],C1[1]); a=MX3(a,C1[2],C1[3]); \
      _Pragma("unroll") for(int r=4;r<16;r+=4){a=MX3(a,C0[r],C0[r+1]);b=MX3(b,C0[r+2],C0[r+3]);a=MX3(a,C1[r],C1[r+1]);b=MX3(b,C1[r+2],C1[r+3]);} \
      float rm=__builtin_fmaxf(a,b); { auto rr=__builtin_amdgcn_permlane32_swap(__float_as_uint(rm),__float_as_uint(rm),false,false); rm=__builtin_fmaxf(__uint_as_float(rr[0]),__uint_as_float(rr[1])); } \
      resc=false; \
      if(__builtin_expect(__any(rm>(float)THRL),0)){ const float dl=__builtin_fmaxf(rm,0.f); mhat+=dl; \
        _Pragma("unroll") for(int r=0;r<16;++r){C0[r]-=dl;C1[r]-=dl;} \
        QMSET(); \
        const float f=__builtin_amdgcn_exp2f(-dl); l_reg*=f; if(hi==0)wsf[r32]=f; resc=true; } } \
    SBAR(); \
    GAPB(o[0]=__builtin_amdgcn_mfma_f32_32x32x16_bf16(PAF(0),VFR(0),o[0],0,0,0), C0,0); \
    GAPB(o[1]=__builtin_amdgcn_mfma_f32_32x32x16_bf16(PAF(0),VFR(4),o[1],0,0,0), C0,4); \
    if(GL){KBLD((t)+1,ka0,ka1);} KRD(GL,0); GAPB(o[0]=__builtin_amdgcn_mfma_f32_32x32x16_bf16(PAF(1),VFR(1),o[0],0,0,0), C0,8); \
    KRD(GL,1); GAPB(o[1]=__builtin_amdgcn_mfma_f32_32x32x16_bf16(PAF(1),VFR(5),o[1],0,0,0), C0,12); \
    KRD(GL,2); GAPB(o[0]=__builtin_amdgcn_mfma_f32_32x32x16_bf16(PAF(2),VFR(2),o[0],0,0,0), C1,0); \
    KRD(GL,3); GAPB(o[1]=__builtin_amdgcn_mfma_f32_32x32x16_bf16(PAF(2),VFR(6),o[1],0,0,0), C1,4); \
    GAPB(o[0]=__builtin_amdgcn_mfma_f32_32x32x16_bf16(PAF(3),VFR(3),o[0],0,0,0), C1,8); \
    GAPB(o[1]=__builtin_amdgcn_mfma_f32_32x32x16_bf16(PAF(3),VFR(7),o[1],0,0,0), C1,12); \
    }while(0)
  int t=1;
  #undef CMASK
  #define CMASK(P0,P1,t) do{}while(0)
  for(;t+5<NT;t+=2){
    STEP(pB0,pB1,pA0,pA1,t,true,true,true);     WAIT_BAR(2); RESC(); ROT();
    STEP(pA0,pA1,pB0,pB1,t+1,true,true,true);   WAIT_BAR(2); RESC(); ROT();
  }
  #undef CMASK
  #define CMASK(P0,P1,t) do{int jb_=(t)-(NT-4); if(jb_>=0)cmask(P0,P1,jb_,qrel,hi);}while(0)
  #define ENDW(tt) do{ if((tt)+3<NT){WAIT_BAR(2);} else if((tt)+2<NT){WAIT_BAR(1);} else {WAIT_BAR(0);} }while(0)
  for(;t+1<NT;t+=2){
    STEP(pB0,pB1,pA0,pA1,t,(t+3<NT),(t+1<NT),(t+1<NT));       ENDW(t);   RESC(); ROT();
    STEP(pA0,pA1,pB0,pB1,t+1,(t+4<NT),(t+2<NT),(t+2<NT));     ENDW(t+1); RESC(); ROT();
  }
  STEP(pB0,pB1,pA0,pA1,NT-1,false,false,false); RESC();
  { float sacc=pB0[0]+pB0[1]; _Pragma("unroll") for(int r=2;r<16;++r)sacc+=pB0[r]; _Pragma("unroll") for(int r=0;r<16;++r)sacc+=pB1[r]; l_reg+=sacc;
    pw0=(u32x4){PKW(pB0,0),PKW(pB0,2),PKW(pB0,4),PKW(pB0,6)};pw1=(u32x4){PKW(pB0,8),PKW(pB0,10),PKW(pB0,12),PKW(pB0,14)};pw2=(u32x4){PKW(pB1,0),PKW(pB1,2),PKW(pB1,4),PKW(pB1,6)};pw3=(u32x4){PKW(pB1,8),PKW(pB1,10),PKW(pB1,12),PKW(pB1,14)};
    SBAR(); pv(o,vb0+sl_cur,PAF(0),PAF(1),PAF(2),PAF(3)); }
  #undef PKW
  #undef PAF
  #undef VFR
  #undef PIN
  #undef MX3
  #undef GAPA
  #undef GAPB
  #undef EX
  #undef VRD
  #undef KRD
  #undef STEP
  #undef ENDW
  {auto rr=__builtin_amdgcn_permlane32_swap(__float_as_uint(l_reg),__float_as_uint(l_reg),false,false);l_reg=__uint_as_float(rr[0])+__uint_as_float(rr[1]);}
  if(hi==0)wsf[32+r32]=l_reg;asm volatile("s_waitcnt lgkmcnt(0)":::"memory");
  float rli[16];
  #pragma unroll
  for(int r=0;r<16;++r)rli[r]=__builtin_amdgcn_rcpf(wsf[32+crow(r,hi)]);
  bf16*Ow=O+(rowbase+q0+wid*QBLK)*DM+h*D;
  { bf16*stg=(bf16*)(shm+LDS_OST)+wid*2048;
    #pragma unroll
    for(int r=0;r<16;++r){const int orow=crow(r,hi);
      #pragma unroll
      for(int d0=0;d0<2;++d0)stg[orow*64+d0*32+r32]=__float2bfloat16(o[d0][r]*rli[r]);}
    asm volatile("s_waitcnt lgkmcnt(0)":::"memory");
    #pragma unroll
    for(int i=0;i<4;++i){const int row=i*8+(lane>>3),ch=lane&7; const u32x4 v=*(const u32x4*)(stg+row*64+ch*8); ATTN_STORE16(Ow+(long)row*DM+ch*8,v);} }
  asm volatile("s_waitcnt lgkmcnt(0)\n\ts_barrier":::"memory");
  #undef DMA_K
  #undef KBLD
  #undef QMSET
  #undef DMA_V
  #undef CMASK
  #undef START
  #undef RESC
  #undef ROT
}
constexpr int ATTN_LDS_BYTES=LDS_BYTES;
struct AttnTensors { const bf16* Q; const bf16* K; const bf16* V; bf16* O; const float* CB; };
struct AttnUnit { int bh; int qb; };
struct StaticOrder {
  int vcu;
  __device__ __forceinline__ explicit StaticOrder(int grid,int block):vcu((block%8)*(grid/8)+block/8){}
  __device__ __forceinline__ bool next(int i,AttnUnit&u)const{ if(i>=8)return false; const int s=vcu&7; u.bh=vcu>>3; const int j=7-i; u.qb=(j&1)?(16*(j>>1)+15-s):(16*(j>>1)+s); return true; }
  __device__ __forceinline__ void a_ready(const AttnUnit&)const{}
  __device__ __forceinline__ void done(const AttnUnit&)const{}
};
template<int THRL=8> __device__ __forceinline__ void attn_phase_dyn(char*lds,const AttnTensors&T,unsigned*qcnt,const unsigned*kmaxbits){
  const lds_cptr l3=(lds_cptr)lds; __attribute__((address_space(3))) int*uslot=(__attribute__((address_space(3))) int*)(l3+LDS_KB+SEQ*4+16);
  const unsigned x=(unsigned)__builtin_amdgcn_s_getreg((3<<11)|20)&7u;
  for(int it=0;;++it){
    if(threadIdx.x==0){ int u=-1;
      for(unsigned k=0;k<8u;++k){ const unsigned q=(x+k)&7u; const unsigned idx=__hip_atomic_fetch_add(qcnt+64*q,1u,__ATOMIC_RELAXED,__HIP_MEMORY_SCOPE_AGENT); if(idx<256u){u=(int)(q*256u+idx);break;} }
      uslot[it&1]=u; }
    asm volatile("s_waitcnt vmcnt(0) lgkmcnt(0)\n\ts_barrier":::"memory");
    const int u=__builtin_amdgcn_readfirstlane(uslot[it&1]);
    if(u<0)break;
    const int q=u>>8,idx=u&255,bh=4*q+(idx&3),qb=63-(idx>>2);
    attn_unit<THRL>(bh/NHEAD,bh%NHEAD,qb,T.Q,T.K,T.V,T.O,T.CB,__builtin_sqrtf(__uint_as_float(kmaxbits[2*bh])+__uint_as_float(kmaxbits[2*bh+1])),lds);
  }
}
template<class Sched,int THRL=8> __device__ __forceinline__ void attn_phase(char*lds,const AttnTensors&T,const Sched&S){
  AttnUnit u;
  for(int i=0;S.next(i,u);++i){ S.a_ready(u); attn_unit<THRL>(u.bh/NHEAD,u.bh%NHEAD,u.qb,T.Q,T.K,T.V,T.O,T.CB,1e30f,lds); S.done(u); }
}
#undef SBAR
#undef WAIT_BAR
}
constexpr int NWAVES = 8, NTHREADS = 512;
constexpr int BATCH = 2, SEQ = 16384, D = 1024, M = BATCH * SEQ, NH = 16, FFH = 2816, SGW = 2048, QKVN = 3088;
constexpr float LOG2E = 1.4426950408889634f;
constexpr size_t MiB = 1u << 20;
constexpr size_t WS_W = 0, WS_WSTRIDE = 32 * MiB;
constexpr size_t WS_XB = 128 * MiB;
constexpr size_t WS_BIG = 192 * MiB;
constexpr size_t WS_WA = 0;
constexpr size_t WS_WB = 8 * MiB;
constexpr size_t WS_WF1 = 12 * MiB;
constexpr size_t WS_WF2 = 23 * MiB;
constexpr size_t WS_WS = 28 * MiB + 524288;
constexpr size_t WS_SSQ = 478 * MiB;
constexpr size_t WS_LNP = 480 * MiB;
constexpr size_t WS_LF = 488 * MiB;
constexpr size_t WS_CB = 490 * MiB;
constexpr size_t WS_CTL = 492 * MiB;
constexpr size_t WS_BAR = 492 * MiB + 65536;
constexpr size_t WS_END = 493 * MiB;
constexpr int LDS_BYTES = 153600;
static_assert(attn_body::ATTN_LDS_BYTES <= LDS_BYTES && pg8::STAGE_BYTES + 20 * 1024 <= LDS_BYTES - 64, "LDS map");

#define GAS __attribute__((address_space(1)))
#define LAS __attribute__((address_space(3)))
typedef unsigned short bf16;
typedef unsigned v4u __attribute__((ext_vector_type(4)));
typedef unsigned v2u __attribute__((ext_vector_type(2)));
typedef float f32x4 __attribute__((ext_vector_type(4)));
typedef float f32x2 __attribute__((ext_vector_type(2)));
typedef short bf16x8 __attribute__((ext_vector_type(8)));
typedef float f32x16 __attribute__((ext_vector_type(16)));
#define LDS_WAIT() asm volatile("s_waitcnt lgkmcnt(0)" ::: "memory")
__device__ __forceinline__ unsigned f2bf(float f) { unsigned u = __builtin_bit_cast(unsigned, f); return (u + 0x7fffu + ((u >> 16) & 1u)) >> 16; }
__device__ __forceinline__ unsigned pk2(float lo, float hi) { return f2bf(lo) | (f2bf(hi) << 16); }
__device__ __forceinline__ float bf2f(unsigned short b) { return __builtin_bit_cast(float, (unsigned)b << 16); }
__device__ __forceinline__ float wave_sum(float v) {
#pragma unroll
    for (int o = 1; o < 64; o <<= 1) v += __shfl_xor(v, o);
    return v;
}
__device__ __forceinline__ void transpose_item(const float* W, int ldw, int K, const float* nw, bf16* WT, int mode, LAS float* scr, int item, int nblk, int lane) {
    const int kb = item / nblk, nb = item % nblk, k0 = 64 * kb, n0 = 32 * nb;
    const int c0 = mode ? (((n0 & 255) >> 7) * FFH + (n0 >> 8) * 128 + (n0 & 127)) : n0;
    const int c = lane & 7;
    f32x4 w0 = (f32x4){1.f, 1.f, 1.f, 1.f}, w1 = w0; if (nw) { w0 = *(const f32x4*)(nw + k0 + 8 * c); w1 = *(const f32x4*)(nw + k0 + 8 * c + 4); }
    const float* rowp = W + (size_t)k0 * ldw + c0; const unsigned loff = (unsigned)((lane >> 5) * ldw + (lane & 31)); LAS float* sdst = scr + (lane >> 5) * 33 + (lane & 31);
    { float tv[32];
#pragma unroll
      for (int i = 0; i < 32; ++i) { tv[i] = rowp[loff]; rowp += 2 * ldw; }
#pragma unroll
      for (int i = 0; i < 32; ++i) sdst[2 * i * 33] = tv[i]; }
    LDS_WAIT(); asm volatile("" ::: "memory");
#pragma unroll
    for (int j = 0; j < 4; ++j) { const int n = (lane >> 3) + 8 * j; const LAS float* s = scr + (8 * c) * 33 + n;
        v4u o; o.x = pk2(s[0 * 33] * w0.x, s[1 * 33] * w0.y); o.y = pk2(s[2 * 33] * w0.z, s[3 * 33] * w0.w); o.z = pk2(s[4 * 33] * w1.x, s[5 * 33] * w1.y); o.w = pk2(s[6 * 33] * w1.z, s[7 * 33] * w1.w);
        *(GAS v4u*)(WT + (size_t)(n0 + n) * K + k0 + 8 * c) = o; }
    LDS_WAIT(); asm volatile("" ::: "memory");
}
typedef GAS unsigned gu32;
#define RLX_AGENT __ATOMIC_RELAXED, __HIP_MEMORY_SCOPE_AGENT
#define XB_TMO      128
#define XB_XCNT(j)  (256  + 64 * (j))
#define XB_XSUB(j)  (1280 + 64 * (j))
#define XB_XGEN(j)  (2304 + 64 * (j))
#define XB_TOP      3328
#define XB_TOPGEN   3392
#define XCD_BAR_WORDS 3456
#define XB_SPIN_CAP (1u << 18)

__device__ __forceinline__ unsigned xb_ld(unsigned* p)              { return __hip_atomic_load(p, __ATOMIC_RELAXED, __HIP_MEMORY_SCOPE_AGENT); }
__device__ __forceinline__ unsigned xb_add(unsigned* p, unsigned v) { return __hip_atomic_fetch_add(p, v, __ATOMIC_RELAXED, __HIP_MEMORY_SCOPE_AGENT); }
__device__ __forceinline__ unsigned xb_xcc_id() { return (unsigned)__builtin_amdgcn_s_getreg((3 << 11) | 20) & 0xFu; }
#define XB_SPIN(cond, bar) do { unsigned _sp = 0; while (cond) { __builtin_amdgcn_s_sleep(1); \
    if ((++_sp & 255u) == 0u) { if (xb_ld(&(bar)[XB_TMO])) break; if (_sp > XB_SPIN_CAP) { atomicAdd(&(bar)[XB_TMO], 1u); break; } } } } while (0)

struct XcdBarrier {
    unsigned* bar; unsigned x;
    volatile LAS unsigned* st;
};

__device__ __forceinline__ XcdBarrier xcd_barrier_post(unsigned* bar, volatile LAS unsigned* st) {
    XcdBarrier b; b.bar = bar; b.x = xb_xcc_id(); b.st = st;
    if (threadIdx.x == 0) (void)xb_add(&bar[XB_XCNT(b.x)], 1u);
    return b;
}
__device__ __forceinline__ void xcd_barrier_complete(unsigned* bar, unsigned x, unsigned& nloc, unsigned& nx) {
    const unsigned G = gridDim.x * gridDim.y * gridDim.z;
    unsigned sum, cnt, mine, sp = 0u;
    for (;;) {
        sum = 0u; cnt = 0u; mine = 0u;
#pragma unroll
        for (unsigned j = 0; j < 16; ++j) { const unsigned c = xb_ld(&bar[XB_XCNT(j)]); sum += c; cnt += (c > 0u) ? 1u : 0u; mine = (j == x) ? c : mine; }
        if (sum == G) break;
        __builtin_amdgcn_s_sleep(1);
        if ((++sp & 255u) == 0u) { if (xb_ld(&bar[XB_TMO])) break; if (sp > XB_SPIN_CAP) { atomicAdd(&bar[XB_TMO], 1u); break; } }
    }
    nloc = mine > 0u ? mine : 1u; nx = cnt > 0u ? cnt : 1u;
}

__device__ __forceinline__ void xcd_barrier(const XcdBarrier& b) {
    asm volatile("s_waitcnt vmcnt(0)" ::: "memory");
    __syncthreads();
    if (threadIdx.x == 0) {
        unsigned* bar = b.bar;
        __builtin_amdgcn_s_waitcnt(0);
        unsigned nloc = b.st[0], nx = b.st[1];
        if (nloc == 0u) { xcd_barrier_complete(bar, b.x, nloc, nx); b.st[0] = nloc; b.st[1] = nx; }
        const unsigned old = xb_add(&bar[XB_XSUB(b.x)], 1u);
        const unsigned gen = old / nloc;
        if (old + 1u == (gen + 1u) * nloc) {
            __builtin_amdgcn_fence(__ATOMIC_RELEASE, "agent");
            asm volatile("s_waitcnt vmcnt(0)" ::: "memory");
            const unsigned og = xb_add(&bar[XB_TOP], 1u);
            const unsigned tg = og / nx;
            if (og + 1u == (tg + 1u) * nx) xb_add(&bar[XB_TOPGEN], 1u);
            else XB_SPIN(xb_ld(&bar[XB_TOPGEN]) == tg, bar);
            __builtin_amdgcn_fence(__ATOMIC_ACQUIRE, "agent");
            xb_add(&bar[XB_XGEN(b.x)], 1u);
            asm volatile("s_waitcnt vmcnt(0)" ::: "memory");
        } else {
            XB_SPIN(xb_ld(&bar[XB_XGEN(b.x)]) == gen, bar);
            __builtin_amdgcn_fence(__ATOMIC_ACQUIRE, "agent");
            asm volatile("s_waitcnt vmcnt(0)" ::: "memory");
        }
    }
    __syncthreads();
}

struct Args { const float* in[15]; float* out; unsigned char* ws; };
typedef __attribute__((address_space(4))) const Args* KArgs;
#define KARGS() ({ KArgs p_ = (KArgs)__builtin_amdgcn_kernarg_segment_ptr(); asm volatile("" : "+s"(p_)); p_; })

__device__ __forceinline__ void convert_weights(KArgs ka, int L, LAS unsigned char* lds, int gw, int NGW, int wave, int lane, int it0, int itstep, bool items, bool tril) {
    const int j = L >> 1; const bool attn = (L & 1) == 0;
    LAS float* scr = (LAS float*)(lds + wave * 16384);
    Args a; _Pragma("unroll") for (int i_ = 0; i_ < 15; ++i_) a.in[i_] = ka->in[i_]; a.out = ka->out; a.ws = ka->ws; unsigned char* ws = a.ws + WS_W + (size_t)L * WS_WSTRIDE;
    const float* W0 = attn ? a.in[2] + (size_t)j * D * QKVN : a.in[5] + (size_t)j * D * 4096;  const int ld0 = attn ? QKVN : 4096, nb0 = attn ? 96 : 128;
    const float* W1 = attn ? a.in[4] + (size_t)j * D * D : a.in[10] + (size_t)j * SGW * D;     const int K1 = attn ? D : SGW;
    const float* W2 = a.in[12] + (size_t)L * D * 2 * FFH;
    const float* W3 = a.in[13] + (size_t)L * FFH * D;
    const int I0 = 16 * nb0, I1 = (K1 / 64) * 32, I2 = 16 * 176, I3 = 44 * 32, NI = I0 + I1 + I2 + I3;
    if (items) for (int it = it0; it < NI; it += itstep) {
        int r = it;
        if (r < I0) { transpose_item(W0, ld0, D, a.in[1] + L * D, (bf16*)(ws + WS_WA), 0, scr, r, nb0, lane); continue; } r -= I0;
        if (r < I1) { transpose_item(W1, D, K1, nullptr, (bf16*)(ws + WS_WB), 0, scr, r, 32, lane); continue; } r -= I1;
        if (r < I2) { transpose_item(W2, 2 * FFH, D, a.in[11] + L * D, (bf16*)(ws + WS_WF1), 1, scr, r, 176, lane); continue; } r -= I2;
        transpose_item(W3, D, FFH, nullptr, (bf16*)(ws + WS_WF2), 0, scr, r, 32, lane);
    }
    if (!attn && tril) {
        const float* Wsrc = a.in[8] + (size_t)j * 16 * 128 * 128; bf16* Wd = (bf16*)(ws + WS_WS);
        for (int i = (gw * 64 + lane) * 4; i < 16 * 128 * 128; i += NGW * 64 * 4) { const f32x4 v = *(const f32x4*)(Wsrc + i); const int t = (i >> 7) & 127, s = i & 127;
            v2u o; o.x = pk2(s <= t ? v[0] : 0.f, s + 1 <= t ? v[1] : 0.f); o.y = pk2(s + 2 <= t ? v[2] : 0.f, s + 3 <= t ? v[3] : 0.f); *(v2u*)(Wd + i) = o; }
    }
}
__device__ __forceinline__ float log_sigmoid_f(float z) { return z >= 0.f ? -log1pf(expf(-z)) : z - log1pf(expf(z)); }
__device__ __forceinline__ void attn_row_pass(KArgs ka, int L, bool first, LAS unsigned char* lds, int gw, int NGW, int tid, int lane) {
    Args a; _Pragma("unroll") for (int i_ = 0; i_ < 15; ++i_) a.in[i_] = ka->in[i_]; a.out = ka->out; a.ws = ka->ws; const int j = L >> 1; unsigned char* ws = a.ws;
    LAS float* wf = (LAS float*)lds;
    const float* Wg = a.in[2] + (size_t)j * D * QKVN + 3072; const float* nw = a.in[1] + L * D;
    for (int idx = tid; idx < D * 16; idx += NTHREADS) { const int k = idx >> 4, h = idx & 15; wf[(((k & 3) + 4 * (k >> 8)) * 64 + ((k & 255) >> 2)) * 20 + h] = nw[k] * Wg[(size_t)k * QKVN + h]; }
    __syncthreads();
    const float* xsrc = a.in[0];
    bf16* XB = (bf16*)(ws + WS_XB); float* ssq = (float*)(ws + WS_SSQ); float* LF = (float*)(ws + WS_LF);
    const float bfv = a.in[3][j * 16 + (lane >> 2)];
    f32x4 nf[4]; v2u nb[4];
#define ROW_LOAD(r_) do { if (first) { const GAS f32x4* xr_ = (const GAS f32x4*)(xsrc + (size_t)(r_) * D) + lane; _Pragma("unroll") for (int q_ = 0; q_ < 4; ++q_) nf[q_] = xr_[64 * q_]; } \
                          else { const GAS v2u* xb_ = (const GAS v2u*)(XB + (size_t)(r_) * D) + lane; _Pragma("unroll") for (int q_ = 0; q_ < 4; ++q_) nb[q_] = xb_[64 * q_]; } } while (0)
    if (gw < M) ROW_LOAD(gw);
    for (int row = gw; row < M; row += NGW) {
        GAS v2u* xb = (GAS v2u*)(XB + (size_t)row * D) + lane;
        f32x4 v[4]; float s2 = 0.f;
        if (first) {
#pragma unroll
            for (int q = 0; q < 4; ++q) { const f32x4 t = nf[q]; v2u o; o.x = pk2(t.x, t.y); o.y = pk2(t.z, t.w); xb[64 * q] = o;
                v[q] = (f32x4){__builtin_bit_cast(float, o.x << 16), __builtin_bit_cast(float, o.x & 0xffff0000u), __builtin_bit_cast(float, o.y << 16), __builtin_bit_cast(float, o.y & 0xffff0000u)}; }
        } else {
#pragma unroll
            for (int q = 0; q < 4; ++q) { const v2u o = nb[q];
                v[q] = (f32x4){__builtin_bit_cast(float, o.x << 16), __builtin_bit_cast(float, o.x & 0xffff0000u), __builtin_bit_cast(float, o.y << 16), __builtin_bit_cast(float, o.y & 0xffff0000u)}; }
        }
        if (row + NGW < M) ROW_LOAD(row + NGW);
#pragma unroll
        for (int q = 0; q < 4; ++q) s2 += (v[q].x * v[q].x + v[q].y * v[q].y) + (v[q].z * v[q].z + v[q].w * v[q].w);
        s2 = wave_sum(s2);
        const float rstd = 1.0f / sqrtf(s2 * (1.0f / D) + 1e-6f);
        if (first && lane < 16) ssq[(size_t)row * 16 + lane] = lane == 0 ? s2 : 0.f;
        float acc[16];
#pragma unroll
        for (int h = 0; h < 16; ++h) acc[h] = 0.f;
#pragma unroll
        for (int q = 0; q < 4; ++q)
#pragma unroll
            for (int e = 0; e < 4; ++e) { const float xv = v[q][e]; const LAS f32x4* wr = (const LAS f32x4*)(wf + ((e + 4 * q) * 64 + lane) * 20);
#pragma unroll
                for (int c = 0; c < 4; ++c) { const f32x4 w = wr[c]; acc[4 * c] += xv * w.x; acc[4 * c + 1] += xv * w.y; acc[4 * c + 2] += xv * w.z; acc[4 * c + 3] += xv * w.w; }
                if (e & 1) asm volatile("" ::: "memory"); }
#define TR_STEP(N, MASK) _Pragma("unroll") for (int i = 0; i < N; ++i) { const bool up = (lane & MASK) != 0; const float keep = up ? acc[i + N] : acc[i], send = up ? acc[i] : acc[i + N]; acc[i] = keep + __shfl_xor(send, MASK); }
        TR_STEP(8, 32) TR_STEP(4, 16) TR_STEP(2, 8) TR_STEP(1, 4)
#undef TR_STEP
        float tot = acc[0]; tot += __shfl_xor(tot, 2); tot += __shfl_xor(tot, 1);
        if ((lane & 3) == 0) { const int b = row / SEQ, t = row % SEQ, h = lane >> 2; LF[((size_t)b * NH + h) * SEQ + t] = log_sigmoid_f(rstd * tot + bfv); }
    }
#undef ROW_LOAD
    __syncthreads();
}
__device__ __forceinline__ void scan_part(const float* LF, float* CB, int bx, LAS unsigned char* lds, int tid) {
    LAS double* red = (LAS double*)lds;
    const int bh = bx >> 3, p = bx & 7, lane = tid & 63, wv = tid >> 6;
    const f32x4* src = (const f32x4*)(LF + (size_t)bh * SEQ);
    double pre = 0.0;
    for (int i = tid; i < 512 * p; i += NTHREADS) { const f32x4 v = src[i]; pre += ((double)v.x + (double)v.y) + ((double)v.z + (double)v.w); }
    const f32x4 v = src[512 * p + tid];
    const double s0 = (double)v.x, s1 = s0 + (double)v.y, s2 = s1 + (double)v.z, s3 = s2 + (double)v.w;
    double inc = s3;
#pragma unroll
    for (int o = 1; o < 64; o <<= 1) { const double t = __shfl_up(inc, o); if (lane >= o) inc += t; }
#pragma unroll
    for (int o = 1; o < 64; o <<= 1) pre += __shfl_xor(pre, o);
    if (lane == 63) red[wv] = inc; if (lane == 0) red[8 + wv] = pre;
    __syncthreads();
    double base = 0.0;
#pragma unroll
    for (int w = 0; w < 8; ++w) { base += red[8 + w]; if (w < wv) base += red[w]; }
    base += inc - s3;
    f32x4 o; o.x = (float)((base + s0) * 1.4426950408889634); o.y = (float)((base + s1) * 1.4426950408889634); o.z = (float)((base + s2) * 1.4426950408889634); o.w = (float)((base + s3) * 1.4426950408889634);
    *((f32x4*)(CB + (size_t)bh * SEQ) + 512 * p + tid) = o;
    __syncthreads();
}
constexpr int VT_PITCH = 136;
__device__ __forceinline__ void sgu_phase(KArgs ka, int j, int bx, int G, LAS unsigned char* lds, int tid, int wave, int lane) {
    unsigned char* ws = ka->ws; bf16* Z = (bf16*)(ws + WS_BIG); const float* lnp = (const float*)(ws + WS_LNP);
    const int g = bx & 15; const bf16* Wc = (const bf16*)(ws + WS_W + (size_t)(2 * j + 1) * WS_WSTRIDE + WS_WS) + (size_t)g * 128 * 128;
    LAS unsigned* VT = (LAS unsigned*)lds; LAS f32x2* stats = (LAS f32x2*)(lds + 36864);
    const int db = wave & 3, th = wave >> 2, l32 = lane & 31, hi = lane >> 5;
    const int NU = 256 * 16 / G;
    bf16x8 wfr[2][8]; float bias[2];
#pragma unroll
    for (int tt = 0; tt < 2; ++tt) { const int t = (2 * th + tt) * 32 + l32; bias[tt] = (ka->in[9] + ((size_t)j * 16 + g) * 128)[t];
#pragma unroll
        for (int ks = 0; ks < 8; ++ks) wfr[tt][ks] = *(const bf16x8*)(Wc + (size_t)t * 128 + ks * 16 + 8 * hi); }
    const int cch = tid & 15, rpb = tid >> 4;
    f32x4 lg0, lg1, lb0, lb1;
    { const float* lng = ka->in[6] + (size_t)j * SGW + g * 128 + 8 * cch; const float* lnb = ka->in[7] + (size_t)j * SGW + g * 128 + 8 * cch;
      lg0 = *(const f32x4*)lng; lg1 = *(const f32x4*)(lng + 4); lb0 = *(const f32x4*)lnb; lb1 = *(const f32x4*)(lnb + 4); }
    const int sr = tid >> 2, spart = tid & 3;
    v4u vr[2][2]; f32x4 lp[4]; v4u ur[2][2];
#define SGU_LOAD_LNP(c_) do { const f32x4* p_ = (const f32x4*)(lnp + ((size_t)((c_) * 128 + sr) * 32 + spart * 8) * 2); _Pragma("unroll") for (int i_ = 0; i_ < 4; ++i_) lp[i_] = p_[i_]; } while (0)
#define SGU_LOAD_V(c_) do { _Pragma("unroll") for (int i_ = 0; i_ < 2; ++i_) { const bf16* p_ = Z + (size_t)((c_) * 128 + 2 * (rpb + 32 * i_)) * 4096 + SGW + g * 128 + 8 * cch; vr[i_][0] = *(const v4u*)p_; vr[i_][1] = *(const v4u*)(p_ + 4096); } } while (0)
#define SGU_UPTR(c_, tt_) (Z + (size_t)((c_) * 128 + (2 * th + (tt_)) * 32 + l32) * 4096 + g * 128 + db * 32 + 8 * hi)
#define SGU_LOAD_U(c_) do { _Pragma("unroll") for (int tt_ = 0; tt_ < 2; ++tt_) _Pragma("unroll") for (int c2_ = 0; c2_ < 2; ++c2_) ur[tt_][c2_] = *(const v4u*)(SGU_UPTR(c_, tt_) + 16 * c2_); } while (0)
    int c = bx >> 4; const int cstep = G >> 4;
    SGU_LOAD_LNP(c); SGU_LOAD_V(c); SGU_LOAD_U(c);
    for (int it = 0; it < NU; ++it, c += cstep) {
        const bool more = it + 1 < NU; const int cn = more ? c + cstep : c;
        { float s1 = 0.f, s2 = 0.f;
#pragma unroll
          for (int i = 0; i < 4; ++i) { s1 += lp[i].x + lp[i].z; s2 += lp[i].y + lp[i].w; }
          s1 += __shfl_xor(s1, 1); s1 += __shfl_xor(s1, 2); s2 += __shfl_xor(s2, 1); s2 += __shfl_xor(s2, 2);
          const float mean = s1 * (1.0f / SGW), var = s2 * (1.0f / SGW) - mean * mean;
          if (spart == 0) stats[sr] = (f32x2){mean, 1.0f / sqrtf(var + 1e-5f)}; }
        if (more) SGU_LOAD_LNP(cn);
        __syncthreads();
#pragma unroll
        for (int i = 0; i < 2; ++i) { const int rp = rpb + 32 * i, s = 2 * rp; const f32x2 st0 = stats[s], st1 = stats[s + 1];
#pragma unroll
            for (int e = 0; e < 8; ++e) { const unsigned w0 = vr[i][0][e >> 1], w1 = vr[i][1][e >> 1];
                const float x0 = bf2f((unsigned short)((e & 1) ? (w0 >> 16) : (w0 & 0xffffu))), x1 = bf2f((unsigned short)((e & 1) ? (w1 >> 16) : (w1 & 0xffffu)));
                const float gg = e < 4 ? lg0[e & 3] : lg1[e & 3], bb = e < 4 ? lb0[e & 3] : lb1[e & 3];
                VT[(8 * cch + e) * 68 + 4 * ((rp >> 2) ^ (cch & 7)) + (rp & 3)] = pk2((x0 - st0.x) * st0.y * gg + bb, (x1 - st1.x) * st1.y * gg + bb); } }
        if (more) SGU_LOAD_V(cn);
        __syncthreads();
#pragma unroll
        for (int tt = 0; tt < 2; ++tt) { const int tb = 2 * th + tt; f32x16 acc = f32x16{};
            const int d = db * 32 + ((l32 & 0x13) | ((l32 & 4) << 1) | ((l32 & 8) >> 1)); const LAS unsigned* vrow = VT + d * 68;
#pragma unroll
            for (int ks = 0; ks < 8; ++ks) if (ks <= 2 * tb + 1) {
                const bf16x8 af = *(const LAS bf16x8*)(vrow + 4 * ((2 * ks + hi) ^ ((d >> 3) & 7)));
                acc = __builtin_amdgcn_mfma_f32_32x32x16_bf16(af, wfr[tt][ks], acc, 0, 0, 0); }
            bf16* urow = SGU_UPTR(c, tt);
#pragma unroll
            for (int c2 = 0; c2 < 2; ++c2) { const v4u uw = ur[tt][c2]; v4u o;
#pragma unroll
                for (int e = 0; e < 4; ++e) { const unsigned wv = uw[e]; const float ua = bf2f((unsigned short)(wv & 0xffffu)), ub = bf2f((unsigned short)(wv >> 16));
                    o[e] = pk2(ua * (acc[8 * c2 + 2 * e] + bias[tt]), ub * (acc[8 * c2 + 2 * e + 1] + bias[tt])); }
                *(v4u*)(urow + 16 * c2) = o; } }
        if (more) SGU_LOAD_U(cn);
    }
    __syncthreads();
#undef SGU_LOAD_LNP
#undef SGU_LOAD_V
#undef SGU_UPTR
#undef SGU_LOAD_U
}

__global__ void __launch_bounds__(NTHREADS, 2) fox_gmlp_fwd(Args a_unused) {
    extern __shared__ __attribute__((aligned(16))) unsigned char lds_raw[];
    cg::grid_group grid = cg::this_grid();
    LAS unsigned char* lds = (LAS unsigned char*)lds_raw;
    const int G = gridDim.x, bx = blockIdx.x, NGW = G * NWAVES;
    volatile LAS unsigned* MISC = (volatile LAS unsigned*)(lds + LDS_BYTES - 32);
    if (threadIdx.x < 2) MISC[threadIdx.x] = 0u;
    if (bx == 0) { unsigned* bw = (unsigned*)(KARGS()->ws + WS_BAR); for (int i = threadIdx.x; i < XCD_BAR_WORDS; i += NTHREADS) bw[i] = 0u; }
    __syncthreads();
    XcdBarrier bar; bar.bar = nullptr; bar.x = 0; bar.st = nullptr; bool posted = false;
#define GRID_SYNC() do { if (!posted) { grid.sync(); bar = xcd_barrier_post((unsigned*)(KARGS()->ws + WS_BAR), MISC); posted = true; } else xcd_barrier(bar); } while (0)
#define TIDS() int tid_ = threadIdx.x; asm volatile("" : "+v"(tid_)); const int tid = tid_, lane = tid & 63, wave = __builtin_amdgcn_readfirstlane(tid >> 6), gw = bx * NWAVES + wave; (void)lane; (void)gw
#pragma nounroll
    for (int L = 0; L < 4; ++L) {
        const bool attn = (L & 1) == 0; const int j = L >> 1;
#pragma nounroll
        for (int part = 0; part < 2; ++part) {
            pg8::Gemm gr;
#define WSP() (KARGS()->ws)
            if (part == 0) {
                if (attn) { TIDS();
                    if (L == 0) {
                        convert_weights(KARGS(), 0, lds, gw, NGW, wave, lane, gw, NGW, true, false);
#pragma nounroll
                        for (int LL = 1; LL < 4; LL += 2) convert_weights(KARGS(), LL, lds, gw, NGW, wave, lane, 0, 1, false, true);
                        __syncthreads(); }
                    if (bx == 0) { unsigned* ctl = (unsigned*)(KARGS()->ws + WS_CTL); ctl[tid] = 0u; ctl[tid + 512] = 0u; }
                    attn_row_pass(KARGS(), L, L == 0, lds, gw, NGW, tid, lane);
                    GRID_SYNC(); }
                if (attn) {
#ifndef NO_SCAN
                    if (G == 8 * BATCH * NH) { TIDS(); unsigned char* ws = WSP(); scan_part((const float*)(ws + WS_LF), (float*)(ws + WS_CB), bx, lds, tid); }
#endif
#ifndef NO_QKV
                    { unsigned char* ws = WSP(); pg8::Gemm g{(const bf16*)(ws + WS_XB), (const bf16*)(ws + WS_W + (size_t)L * WS_WSTRIDE + WS_WA), M, 3 * D, D, D}; pg8::StaticOrder S; S.init(M, 3 * D, G, bx);
                      pg8::rstd_table(lds, (const float*)(ws + WS_SSQ), S); pg8::EpiQKV E{(bf16*)(ws + WS_BIG), (size_t)M * D, (const LAS float*)(lds + pg8::RTAB_OFF), attn_body::C2, (unsigned*)(ws + WS_CTL)};
                      pg8::gemm_phase<pg8::EpiQKV, pg8::StaticOrder, true, true>(lds, g, S, E); }
#endif
                    GRID_SYNC();
#ifndef NO_ATTN
                    { unsigned char* ws = WSP(); bf16* BIG = (bf16*)(ws + WS_BIG); const attn_body::AttnTensors AT{(const attn_body::bf16*)BIG, (const attn_body::bf16*)(BIG + (size_t)M * D), (const attn_body::bf16*)(BIG + (size_t)2 * M * D), (attn_body::bf16*)BIG, (const float*)(ws + WS_CB)};
                      attn_body::attn_phase_dyn<8>((char*)lds_raw, AT, (unsigned*)(ws + WS_CTL) + 64, (const unsigned*)(ws + WS_CTL)); }
                    {
                        TIDS(); LAS int* cslot = (LAS int*)(lds + LDS_BYTES - 64); constexpr int NI1 = 2048 + 1024 + 2816 + 1408, NI2 = 1536 + 512 + 2816 + 1408; const int gbase = (L == 0) ? 0 : NI1 + NI2, NTOT = (L == 0) ? NI1 + NI2 : 2 * NI1 + NI2;
                        for (int itb = 0;; ++itb) {
                            __syncthreads();
                            if (tid == 0) cslot[itb & 1] = (int)__hip_atomic_fetch_add((unsigned*)(KARGS()->ws + WS_CTL) + 600, 1u, __ATOMIC_RELAXED, __HIP_MEMORY_SCOPE_AGENT);
                            __syncthreads();
                            const int gi = gbase + cslot[itb & 1] * 8 + wave; if (gi - wave >= NTOT) break;
                            if (gi < NTOT) { const int LL = gi < NI1 ? 1 : (gi < NI1 + NI2 ? 2 : 3), it = gi - (LL == 1 ? 0 : (LL == 2 ? NI1 : NI1 + NI2));
                                convert_weights(KARGS(), LL, lds, gw, NGW, wave, lane, it, 1 << 30, true, false); } }
                        __syncthreads(); }
#endif
                    GRID_SYNC();
                    gr = pg8::Gemm{nullptr, nullptr, M, D, D, D};
                } else {
#ifndef NO_GELU
                    { unsigned char* ws = WSP(); pg8::Gemm g{(const bf16*)(ws + WS_XB), (const bf16*)(ws + WS_W + (size_t)L * WS_WSTRIDE + WS_WA), M, 4096, D, D}; pg8::StaticOrder S; S.init(M, 4096, G, bx);
                      pg8::rstd_table(lds, (const float*)(ws + WS_SSQ), S); pg8::EpiGeluLN E{(bf16*)(ws + WS_BIG), (const LAS float*)(lds + pg8::RTAB_OFF), (float*)(ws + WS_LNP)};
                      pg8::gemm_phase<pg8::EpiGeluLN, pg8::StaticOrder, true, true>(lds, g, S, E); }
#endif
                    GRID_SYNC();
#ifndef NO_SGU
                    { TIDS(); sgu_phase(KARGS(), j, bx, G, lds, tid, wave, lane); }
#endif
                    GRID_SYNC();
                    gr = pg8::Gemm{nullptr, nullptr, M, D, SGW, 4096};
                }
            } else {
#ifndef NO_SWI
                { unsigned char* ws = WSP(); pg8::Gemm g{(const bf16*)(ws + WS_XB), (const bf16*)(ws + WS_W + (size_t)L * WS_WSTRIDE + WS_WF1), M, 2 * FFH, D, D}; pg8::StaticOrder S; S.init(M, 2 * FFH, G, bx);
                  pg8::rstd_table(lds, (const float*)(ws + WS_SSQ), S); pg8::EpiSwiGLU E{(bf16*)(ws + WS_BIG), (const LAS float*)(lds + pg8::RTAB_OFF), FFH};
                  pg8::gemm_phase<pg8::EpiSwiGLU, pg8::StaticOrder, true, true>(lds, g, S, E); }
#endif
                GRID_SYNC();
                gr = pg8::Gemm{nullptr, nullptr, M, D, FFH, FFH};
            }
#ifndef NO_RES
            { unsigned char* ws = WSP(); gr.A = (const bf16*)(ws + WS_BIG); gr.Bt = (const bf16*)(ws + WS_W + (size_t)L * WS_WSTRIDE + (part == 0 ? WS_WB : WS_WF2)); pg8::StaticOrder S; S.init(M, D, G, bx); pg8::EpiRes E{(bf16*)(ws + WS_XB), (float*)(ws + WS_SSQ)};
              pg8::gemm_phase<pg8::EpiRes, pg8::StaticOrder, true, true>(lds, gr, S, E); }
#endif
            GRID_SYNC();
        }
    }
    { TIDS(); const KArgs ka = KARGS(); Args a; _Pragma("unroll") for (int i_ = 0; i_ < 15; ++i_) a.in[i_] = ka->in[i_]; a.out = ka->out; a.ws = ka->ws; const float* fw = a.in[14]; const bf16* XBf = (const bf16*)(a.ws + WS_XB);
      f32x4 fwv[4]; v2u nx[4];
#pragma unroll
      for (int q = 0; q < 4; ++q) fwv[q] = *((const f32x4*)fw + lane + 64 * q);
      if (gw < M) { const GAS v2u* xr = (const GAS v2u*)(XBf + (size_t)gw * D) + lane;
#pragma unroll
        for (int q = 0; q < 4; ++q) nx[q] = xr[64 * q]; }
      for (int row = gw; row < M; row += NGW) { GAS f32x4* o = (GAS f32x4*)(a.out + (size_t)row * D) + lane;
        f32x4 v[4]; float s2 = 0.f;
#pragma unroll
        for (int q = 0; q < 4; ++q) { const v2u t = nx[q]; v[q] = (f32x4){__builtin_bit_cast(float, t.x << 16), __builtin_bit_cast(float, t.x & 0xffff0000u), __builtin_bit_cast(float, t.y << 16), __builtin_bit_cast(float, t.y & 0xffff0000u)}; s2 += (v[q].x * v[q].x + v[q].y * v[q].y) + (v[q].z * v[q].z + v[q].w * v[q].w); }
        if (row + NGW < M) { const GAS v2u* xr = (const GAS v2u*)(XBf + (size_t)(row + NGW) * D) + lane;
#pragma unroll
          for (int q = 0; q < 4; ++q) nx[q] = xr[64 * q]; }
        const float rstd = 1.0f / sqrtf(wave_sum(s2) * (1.0f / D) + 1e-6f);
#pragma unroll
        for (int q = 0; q < 4; ++q) o[64 * q] = v[q] * rstd * fwv[q]; } }
}

extern "C" void kernel_launch(void* const* d_in, const int* in_sizes, int n_in, void* d_out, int out_size, void* d_ws, size_t ws_size, hipStream_t stream) {
    static int grid = 0;
    if (grid == 0) {
        if (n_in != 15 || in_sizes[0] != M * D || out_size != M * D || ws_size < WS_END) { fprintf(stderr, "kernel_launch: unexpected shapes (n_in %d, in0 %d, out %d, ws %zu < %zu); nothing launched\n", n_in, n_in > 0 ? in_sizes[0] : -1, out_size, ws_size, (size_t)WS_END); grid = -1; return; }
        int dev = 0, cus = 0, per_cu = 0;
        hipGetDevice(&dev); hipDeviceGetAttribute(&cus, hipDeviceAttributeMultiprocessorCount, dev);
        if (hipFuncSetAttribute((const void*)fox_gmlp_fwd, hipFuncAttributeMaxDynamicSharedMemorySize, LDS_BYTES) != hipSuccess) { fprintf(stderr, "kernel_launch: hipFuncSetAttribute failed\n"); grid = -1; return; }
        hipOccupancyMaxActiveBlocksPerMultiprocessor(&per_cu, (const void*)fox_gmlp_fwd, NTHREADS, LDS_BYTES);
        (void)hipGetLastError();
        if (per_cu < 1 || cus != 256) { fprintf(stderr, "kernel_launch: needs 256 CUs with one resident workgroup each (cus %d, per_cu %d)\n", cus, per_cu); if (cus != 256 || per_cu < 1) { grid = -1; return; } }
        grid = cus;
    }
    if (grid < 0) return;
    Args a{};
    for (int i = 0; i < 15; ++i) a.in[i] = (const float*)d_in[i];
    a.out = (float*)d_out; a.ws = (unsigned char*)d_ws;
    void* args[] = {&a};
    const hipError_t e = hipLaunchCooperativeKernel((const void*)fox_gmlp_fwd, dim3(grid), dim3(NTHREADS), args, LDS_BYTES, stream);
    if (e != hipSuccess) fprintf(stderr, "kernel_launch: cooperative launch failed: %s (grid %d)\n", hipGetErrorString(e), grid);
}
```

```cpp
#include <hip/hip_runtime.h>
#include <hip/hip_cooperative_groups.h>
#include <cstdio>
#include <cstdint>
namespace cg = cooperative_groups;
namespace pg8 {
#define PG8_LAS __attribute__((address_space(3)))
typedef unsigned short bf16_t;
typedef short bf16x8 __attribute__((ext_vector_type(8)));
typedef float f32x4 __attribute__((ext_vector_type(4)));
typedef unsigned u32x4 __attribute__((ext_vector_type(4)));
typedef unsigned u32x2 __attribute__((ext_vector_type(2)));
constexpr int BM = 256, BK = 64, HALF = 128, HTB = HALF * BK * 2  , STAGE_BYTES = 8 * HTB, NXCD = 8, WGM = 8;

__host__ __device__ __forceinline__ int lds_byte(int r, int c) { return (r >> 3) * 1024 + (r & 7) * 128 + ((((c >> 3) ^ (r >> 1)) & 7) << 4) + (c & 7) * 2; }
__host__ __device__ __forceinline__ void stage_rc(int b, int& R, int& C) { const int st = b >> 10, row = (b >> 7) & 7, pos = (b >> 4) & 7; R = st * 8 + row; C = ((pos ^ (R >> 1)) & 7) << 3; }
__host__ __device__ __forceinline__ int perm32(int rho) { const int n = rho >> 4, i = rho & 15; return 8 * (i >> 2) + 4 * n + (i & 3); }

struct Unit { int pm, pn, ord; };
struct Gemm { const bf16_t* A; const bf16_t* Bt; int M, N, K, lda; };

struct StaticOrder {
    int nM, nN, nwg, G, c;
    __host__ __device__ void init(int M, int N, int G_, int c_) { nM = M / BM; nN = N / BM; nwg = nM * nN; G = G_; c = c_; }
    __host__ __device__ bool next(int i, Unit& u) const {
        const long L = (long)i * G + c; if (L >= nwg) return false;
        int wgid = (int)L; { const int q = nwg / NXCD, r = nwg % NXCD, xcd = wgid % NXCD, off = wgid / NXCD; wgid = (xcd < r ? xcd * (q + 1) : r * (q + 1) + (xcd - r) * q) + off; }
        const int nig = WGM * nN, gid = wgid / nig, fm = gid * WGM, gsz = (nM - fm) < WGM ? (nM - fm) : WGM;
        u.pm = fm + ((wgid % nig) % gsz); u.pn = (wgid % nig) / gsz; u.ord = i; return true;
    }
    __device__ __forceinline__ void a_ready(const Unit&) const {}
    __device__ __forceinline__ void done(const Unit&) const {}
};

__device__ __forceinline__ unsigned cvt_pk_bf16(float lo, float hi) { unsigned r; asm volatile("v_cvt_pk_bf16_f32 %0, %1, %2" : "=v"(r) : "v"(lo), "v"(hi)); return r; }
typedef float f32x2 __attribute__((ext_vector_type(2)));
__device__ __forceinline__ f32x2 gelu_pk(f32x2 v) {
    const f32x2 av = __builtin_elementwise_abs(v), d = av * 0.2316418882f + 1.0f;
    f32x2 t; t.x = __builtin_amdgcn_rcpf(d.x); t.y = __builtin_amdgcn_rcpf(d.y);
    f32x2 q = t * 0.5307027145f + (-0.7265760135f); q = q * t + 0.7107068705f; q = q * t + (-0.142248368f); q = q * t + 0.127414796f; q = q * t;
    const f32x2 s = (v * v) * (-0.72134752044f);
    f32x2 e; e.x = __builtin_amdgcn_exp2f(s.x); e.y = __builtin_amdgcn_exp2f(s.y);
    const f32x2 m = v * (q * e), r = v - m;
    f32x2 o; o.x = v.x < 0.f ? m.x : r.x; o.y = v.y < 0.f ? m.y : r.y; return o;
}
__device__ __forceinline__ float row_rstd(const float* ssq, int row) {
    const f32x4* p = (const f32x4*)(ssq + (size_t)row * 16);
    const f32x4 a = p[0], b = p[1], c = p[2], d = p[3];
    const f32x4 s = (a + b) + (c + d);
    return __builtin_amdgcn_rsqf(((s[0] + s[1]) + (s[2] + s[3])) * (1.0f / 1024.0f) + 1e-6f);
}
constexpr int RTAB_OFF = STAGE_BYTES;
template <class Sched> __device__ __forceinline__ void rstd_table(PG8_LAS unsigned char* lds, const float* ssq, const Sched& S) {
    PG8_LAS float* tab = (PG8_LAS float*)(lds + RTAB_OFF); int tid_ = threadIdx.x; asm volatile("" : "+v"(tid_));
    const int tid = tid_, half = tid >> 8, r = tid & 255; Unit u;
    int lastpm = -1; float val = 0.f;
    for (int i = half; S.next(i, u); i += 2) { if (u.pm != lastpm) { val = row_rstd(ssq, u.pm * BM + r); lastpm = u.pm; } tab[i * 256 + r] = val; }
    __syncthreads();
}
struct EpiQKV {
    static constexpr bool PERM = true, AFTER_DRAIN = false;
    bf16_t* O; size_t split_stride; const PG8_LAS float* rtab; float scale0; unsigned* kmax;
    __device__ __forceinline__ void operator()(const f32x4 (&acc)[2][2][4][2], const Unit& u, int wr, int wc, int fr, int fq) const {
        const int row0 = u.pm * BM + wr * 64 + fr; int colt = u.pn * BM; const int t = colt >> 10; bf16_t* base = O + (size_t)t * split_stride; colt &= 1023;
        const float sc = (t == 0) ? scale0 : 1.f; const int col0 = colt + wc * 32 + 8 * fq; float am[2] = {0.f, 0.f};
#pragma unroll
        for (int ai = 0; ai < 2; ++ai)
#pragma unroll
            for (int m = 0; m < 4; ++m) { const int row = row0 + ai * HALF + m * 16; const float rs = rtab[u.ord * 256 + ai * HALF + wr * 64 + m * 16 + fr] * sc; bf16_t* rowp = base + (size_t)row * 1024 + col0;
#pragma unroll
                for (int bj = 0; bj < 2; ++bj) { const f32x4 v0 = acc[ai][bj][m][0] * rs, v1 = acc[ai][bj][m][1] * rs;
                    u32x4 w; w.x = cvt_pk_bf16(v0[0], v0[1]); w.y = cvt_pk_bf16(v0[2], v0[3]); w.z = cvt_pk_bf16(v1[0], v1[1]); w.w = cvt_pk_bf16(v1[2], v1[3]);
                    *(u32x4*)(rowp + bj * HALF) = w;
                    if (t == 1) {
                        const float f0 = __builtin_bit_cast(float, w.x << 16), f1 = __builtin_bit_cast(float, w.x & 0xffff0000u), f2 = __builtin_bit_cast(float, w.y << 16), f3 = __builtin_bit_cast(float, w.y & 0xffff0000u);
                        const float f4 = __builtin_bit_cast(float, w.z << 16), f5 = __builtin_bit_cast(float, w.z & 0xffff0000u), f6 = __builtin_bit_cast(float, w.w << 16), f7 = __builtin_bit_cast(float, w.w & 0xffff0000u);
                        float s = ((f0 * f0 + f1 * f1) + (f2 * f2 + f3 * f3)) + ((f4 * f4 + f5 * f5) + (f6 * f6 + f7 * f7));
                        s += __shfl_xor(s, 16); s += __shfl_xor(s, 32); am[bj] = __builtin_fmaxf(am[bj], s); } } }
        if (t == 1) {
#pragma unroll
            for (int bj = 0; bj < 2; ++bj) { float v = am[bj];
#pragma unroll
                for (int o = 1; o < 64; o <<= 1) v = __builtin_fmaxf(v, __shfl_xor(v, o));
                if ((fr | fq) == 0) __hip_atomic_fetch_max(kmax + 2 * ((u.pm >> 6) * 16 + (colt >> 6) + 2 * bj + (wc >> 1)) + (wc & 1), __builtin_bit_cast(unsigned, v), __ATOMIC_RELAXED, __HIP_MEMORY_SCOPE_AGENT); } }
    }
};
struct EpiRes {
    static constexpr bool PERM = true, AFTER_DRAIN = false;
    bf16_t* XB; float* ssq;
    __device__ __forceinline__ void operator()(const f32x4 (&acc)[2][2][4][2], const Unit& u, int wr, int wc, int fr, int fq) const {
        const int col0 = u.pn * BM + wc * 32 + 8 * fq;
#pragma unroll
        for (int ai = 0; ai < 2; ++ai) {
            u32x4 xin[4][2];
#pragma unroll
            for (int m = 0; m < 4; ++m) { const size_t off = (size_t)(u.pm * BM + ai * HALF + wr * 64 + m * 16 + fr) * 1024 + col0;
#pragma unroll
                for (int bj = 0; bj < 2; ++bj) xin[m][bj] = *(const u32x4*)(XB + off + bj * HALF); }
#pragma unroll
            for (int m = 0; m < 4; ++m) { const int row = u.pm * BM + ai * HALF + wr * 64 + m * 16 + fr; const size_t off = (size_t)row * 1024 + col0; float q = 0.f;
#pragma unroll
                for (int bj = 0; bj < 2; ++bj) { const u32x4 xi = xin[m][bj]; const f32x4 a0 = acc[ai][bj][m][0], a1 = acc[ai][bj][m][1];
                    const float x0 = __builtin_bit_cast(float, xi.x << 16) + a0[0], x1 = __builtin_bit_cast(float, xi.x & 0xffff0000u) + a0[1], x2 = __builtin_bit_cast(float, xi.y << 16) + a0[2], x3 = __builtin_bit_cast(float, xi.y & 0xffff0000u) + a0[3];
                    const float x4 = __builtin_bit_cast(float, xi.z << 16) + a1[0], x5 = __builtin_bit_cast(float, xi.z & 0xffff0000u) + a1[1], x6 = __builtin_bit_cast(float, xi.w << 16) + a1[2], x7 = __builtin_bit_cast(float, xi.w & 0xffff0000u) + a1[3];
                    u32x4 w; w.x = cvt_pk_bf16(x0, x1); w.y = cvt_pk_bf16(x2, x3); w.z = cvt_pk_bf16(x4, x5); w.w = cvt_pk_bf16(x6, x7); *(u32x4*)(XB + off + bj * HALF) = w;
                    const float r0 = __builtin_bit_cast(float, w.x << 16), r1 = __builtin_bit_cast(float, w.x & 0xffff0000u), r2 = __builtin_bit_cast(float, w.y << 16), r3 = __builtin_bit_cast(float, w.y & 0xffff0000u);
                    const float r4 = __builtin_bit_cast(float, w.z << 16), r5 = __builtin_bit_cast(float, w.z & 0xffff0000u), r6 = __builtin_bit_cast(float, w.w << 16), r7 = __builtin_bit_cast(float, w.w & 0xffff0000u);
                    q += ((r0 * r0 + r1 * r1) + (r2 * r2 + r3 * r3)) + ((r4 * r4 + r5 * r5) + (r6 * r6 + r7 * r7)); }
                q += __shfl_xor(q, 16); q += __shfl_xor(q, 32);
                if (fq == 0) ssq[(size_t)row * 16 + u.pn * 4 + wc] = q; }
            asm volatile("" ::: "memory"); }
    }
};
struct EpiSwiGLU {
    static constexpr bool PERM = true, AFTER_DRAIN = false;
    bf16_t* H; const PG8_LAS float* rtab; int ldh;
    __device__ __forceinline__ void operator()(const f32x4 (&acc)[2][2][4][2], const Unit& u, int wr, int wc, int fr, int fq) const {
        const int row0 = u.pm * BM + wr * 64 + fr, col0 = u.pn * HALF + wc * 32 + 8 * fq;
#pragma unroll
        for (int ai = 0; ai < 2; ++ai)
#pragma unroll
            for (int m = 0; m < 4; ++m) { const int row = row0 + ai * HALF + m * 16; const float rs = rtab[u.ord * 256 + ai * HALF + wr * 64 + m * 16 + fr];
                float h[8];
#pragma unroll
                for (int n = 0; n < 2; ++n)
#pragma unroll
                    for (int e = 0; e < 4; ++e) { const float g = acc[ai][0][m][n][e] * rs, up = acc[ai][1][m][n][e] * rs;
                        h[n * 4 + e] = g * up * __builtin_amdgcn_rcpf(1.0f + __builtin_amdgcn_exp2f(g * -1.4426950408889634f)); }
                u32x4 w; w.x = cvt_pk_bf16(h[0], h[1]); w.y = cvt_pk_bf16(h[2], h[3]); w.z = cvt_pk_bf16(h[4], h[5]); w.w = cvt_pk_bf16(h[6], h[7]);
                *(u32x4*)(H + (size_t)row * ldh + col0) = w; }
    }
};
struct EpiGeluLN {
    static constexpr bool PERM = true, AFTER_DRAIN = false;
    bf16_t* Z; const PG8_LAS float* rtab; float* lnp;
    __device__ __forceinline__ void operator()(const f32x4 (&acc)[2][2][4][2], const Unit& u, int wr, int wc, int fr, int fq) const {
        const int row0 = u.pm * BM + wr * 64 + fr, col0 = u.pn * BM + wc * 32 + 8 * fq; const bool isv = u.pn >= 8;
#pragma unroll
        for (int ai = 0; ai < 2; ++ai)
#pragma unroll
            for (int m = 0; m < 4; ++m) { const int row = row0 + ai * HALF + m * 16; const float rs = rtab[u.ord * 256 + ai * HALF + wr * 64 + m * 16 + fr]; float s1 = 0.f, s2 = 0.f;
#pragma unroll
                for (int bj = 0; bj < 2; ++bj) { const f32x4 v0 = acc[ai][bj][m][0] * rs, v1 = acc[ai][bj][m][1] * rs;
                    const f32x2 a = gelu_pk((f32x2){v0[0], v0[1]}), b = gelu_pk((f32x2){v0[2], v0[3]}), c = gelu_pk((f32x2){v1[0], v1[1]}), d = gelu_pk((f32x2){v1[2], v1[3]});
                    s1 += ((a.x + a.y) + (b.x + b.y)) + ((c.x + c.y) + (d.x + d.y));
                    s2 += ((a.x * a.x + a.y * a.y) + (b.x * b.x + b.y * b.y)) + ((c.x * c.x + c.y * c.y) + (d.x * d.x + d.y * d.y));
                    u32x4 w; w.x = cvt_pk_bf16(a.x, a.y); w.y = cvt_pk_bf16(b.x, b.y); w.z = cvt_pk_bf16(c.x, c.y); w.w = cvt_pk_bf16(d.x, d.y);
                    *(u32x4*)(Z + (size_t)row * 4096 + col0 + bj * HALF) = w; }
                if (isv) { s1 += __shfl_xor(s1, 16); s1 += __shfl_xor(s1, 32); s2 += __shfl_xor(s2, 16); s2 += __shfl_xor(s2, 32);
                    if (fq == 0) *(f32x2*)(lnp + ((size_t)row * 32 + (u.pn - 8) * 4 + wc) * 2) = (f32x2){s1, s2}; } }
    }
};

template <class Epi, class Sched, bool ALIGN_EPI = false, bool SP2 = false>
__device__ __forceinline__ void gemm_phase(PG8_LAS unsigned char* lds, const Gemm g, const Sched& S, const Epi& E) {
    int tid_ = threadIdx.x; asm volatile("" : "+v"(tid_));
    const int tid = tid_, wid = __builtin_amdgcn_readfirstlane(tid >> 6), lane = tid & 63, wr = wid >> 2, wc = wid & 3, fr = lane & 15, fq = lane >> 4;
    const int K = g.K, nt = K / BK;
    unsigned voffA[2], voffB[2];
#pragma unroll
    for (int i = 0; i < 2; ++i) { int R, C; stage_rc(tid * 16 + i * 8192, R, C); const int Rb = Epi::PERM ? ((R & ~31) + perm32(R & 31)) : R;
        voffA[i] = (unsigned)(R * g.lda + C) * 2u; voffB[i] = (unsigned)(Rb * K + C) * 2u; }
    const size_t kstep = (size_t)(BK * 2);
    const size_t hstepA = (size_t)HALF * g.lda * 2, hstepB = (size_t)HALF * K * 2;
    const size_t tstepA = 2 * hstepA, tstepB = 2 * hstepB;
    const unsigned ldsw = (unsigned)wid * 1024u;
    const int aoffk[2] = {lds_byte(wr * 64 + fr, fq * 8), lds_byte(wr * 64 + fr, 32 + fq * 8)}, boffk[2] = {lds_byte(wc * 32 + fr, fq * 8), lds_byte(wc * 32 + fr, 32 + fq * 8)};
#define PG8_SA(b, h) (((b) * 2 + (h)) * HTB)
#define PG8_SB(b, h) ((4 + (b) * 2 + (h)) * HTB)
#define PG8_STAGE(bufoff, gbase, voff) do { _Pragma("unroll") for (int _i = 0; _i < 2; ++_i) \
        __builtin_amdgcn_global_load_lds((const unsigned*)((const char*)(gbase) + (voff)[_i]), (PG8_LAS unsigned*)(lds + (bufoff) + ldsw + _i * 8192), 16, 0, 0); } while (0)
#define PG8_LDA(dst, b, h) do { _Pragma("unroll") for (int m = 0; m < 4; ++m) _Pragma("unroll") for (int k = 0; k < 2; ++k) dst[m][k] = *(const PG8_LAS bf16x8*)(lds + PG8_SA(b, h) + aoffk[k] + m * 2048); } while (0)
#define PG8_LDB(dst, b, h) do { _Pragma("unroll") for (int n = 0; n < 2; ++n) _Pragma("unroll") for (int k = 0; k < 2; ++k) dst[n][k] = *(const PG8_LAS bf16x8*)(lds + PG8_SB(b, h) + boffk[k] + n * 2048); } while (0)
#define PG8_MMA(ai, bj, At, Bt) do { __builtin_amdgcn_s_setprio(1); _Pragma("unroll") for (int m = 0; m < 4; ++m) _Pragma("unroll") for (int n = 0; n < 2; ++n) _Pragma("unroll") for (int k = 0; k < 2; ++k) \
        acc[ai][bj][m][n] = __builtin_amdgcn_mfma_f32_16x16x32_bf16(Bt[n][k], At[m][k], acc[ai][bj][m][n], 0, 0, 0); __builtin_amdgcn_s_setprio(0); } while (0)
#define PG8_WAIT_V(n) asm volatile("s_waitcnt vmcnt(" #n ")" ::: "memory")
#define PG8_WAIT_L(n) asm volatile("s_waitcnt lgkmcnt(" #n ")" ::: "memory")
#define PG8_BAR __builtin_amdgcn_s_barrier()
#define PG8_SCHED __builtin_amdgcn_sched_barrier(0)
    Unit cur, nxt; int ui = 0;
    if (!S.next(0, cur)) return;
    f32x4 acc[2][2][4][2];
#pragma unroll
    for (int a = 0; a < 2; ++a)
#pragma unroll
        for (int b = 0; b < 2; ++b)
#pragma unroll
            for (int m = 0; m < 4; ++m)
#pragma unroll
                for (int n = 0; n < 2; ++n) acc[a][b][m][n] = (f32x4){0.f, 0.f, 0.f, 0.f};
    bf16x8 At[4][2], B0[2][2], B1[2][2];
    const char* cA = (const char*)g.A + (size_t)cur.pm * tstepA; const char* cB = (const char*)g.Bt + (size_t)cur.pn * tstepB;
    S.a_ready(cur);
    if constexpr (SP2) {
        PG8_STAGE(PG8_SB(0, 0), cB, voffB); PG8_STAGE(PG8_SB(0, 1), cB + hstepB, voffB); PG8_STAGE(PG8_SA(0, 0), cA, voffA); PG8_STAGE(PG8_SA(0, 1), cA + hstepA, voffA);
        if (wr == 1) PG8_BAR;
        PG8_WAIT_V(2); PG8_BAR;
        PG8_STAGE(PG8_SB(1, 0), cB + kstep, voffB); PG8_STAGE(PG8_SA(1, 0), cA + kstep, voffA); PG8_STAGE(PG8_SB(1, 1), cB + hstepB + kstep, voffB);
        PG8_WAIT_V(6); PG8_BAR;
    } else {
        PG8_STAGE(PG8_SB(0, 0), cB, voffB); PG8_STAGE(PG8_SA(0, 0), cA, voffA); PG8_STAGE(PG8_SB(0, 1), cB + hstepB, voffB); PG8_STAGE(PG8_SA(0, 1), cA + hstepA, voffA);
        if (wr == 1) PG8_BAR;
        PG8_WAIT_V(4); PG8_BAR;
        PG8_STAGE(PG8_SB(1, 0), cB + kstep, voffB); PG8_STAGE(PG8_SA(1, 0), cA + kstep, voffA); PG8_STAGE(PG8_SB(1, 1), cB + hstepB + kstep, voffB);
        PG8_WAIT_V(6); PG8_BAR;
    }
    for (;;) {
        const bool has_next = S.next(ui + 1, nxt);
        const char* nA = has_next ? (const char*)g.A + (size_t)nxt.pm * tstepA : cA; const char* nB = has_next ? (const char*)g.Bt + (size_t)nxt.pn * tstepB : cB;
        for (int t = 0; t < nt; t += 2) {
            const bool last = (t == nt - 2);
            const char* a1 = cA + (size_t)(t + 1) * kstep;
            const char* a2 = last ? nA : cA + (size_t)(t + 2) * kstep; const char* b2 = last ? nB : cB + (size_t)(t + 2) * kstep;
            const char* a3 = a2 + kstep; const char* b3 = b2 + kstep;
            if (last && has_next) S.a_ready(nxt);
            if constexpr (SP2) {
            PG8_LDB(B0, 0, 0); PG8_LDB(B1, 0, 1); PG8_SCHED; PG8_LDA(At, 0, 0); PG8_STAGE(PG8_SA(1, 1), a1 + hstepA, voffA);
            PG8_WAIT_V(8); PG8_WAIT_L(0); PG8_BAR; PG8_MMA(0, 0, At, B0); PG8_MMA(0, 1, At, B1); PG8_BAR; PG8_SCHED;
            PG8_LDA(At, 0, 1); PG8_STAGE(PG8_SB(0, 0), b2, voffB); PG8_STAGE(PG8_SB(0, 1), b2 + hstepB, voffB); PG8_STAGE(PG8_SA(0, 0), a2, voffA);
            PG8_WAIT_V(8); PG8_WAIT_L(0); PG8_BAR; PG8_MMA(1, 0, At, B0); PG8_MMA(1, 1, At, B1); PG8_BAR; PG8_SCHED;
            PG8_LDB(B0, 1, 0); PG8_LDB(B1, 1, 1); PG8_SCHED; PG8_LDA(At, 1, 0); PG8_STAGE(PG8_SA(0, 1), a2 + hstepA, voffA);
            PG8_WAIT_V(8); PG8_WAIT_L(0); PG8_BAR; PG8_MMA(0, 0, At, B0); PG8_MMA(0, 1, At, B1); PG8_BAR; PG8_SCHED;
            PG8_LDA(At, 1, 1); PG8_STAGE(PG8_SB(1, 0), b3, voffB); PG8_STAGE(PG8_SB(1, 1), b3 + hstepB, voffB); PG8_STAGE(PG8_SA(1, 0), a3, voffA);
            PG8_WAIT_V(8); PG8_WAIT_L(0); PG8_BAR; PG8_MMA(1, 0, At, B0); PG8_MMA(1, 1, At, B1); PG8_BAR; PG8_SCHED;
            } else {
            PG8_LDB(B0, 0, 0); PG8_SCHED; PG8_LDA(At, 0, 0); PG8_STAGE(PG8_SA(1, 1), a1 + hstepA, voffA);
            PG8_WAIT_L(8); PG8_BAR; PG8_WAIT_L(0); PG8_MMA(0, 0, At, B0); PG8_BAR; PG8_SCHED;
            PG8_LDB(B1, 0, 1); PG8_STAGE(PG8_SB(0, 0), b2, voffB);
            PG8_BAR; PG8_WAIT_L(0); PG8_MMA(0, 1, At, B1); PG8_BAR;
            PG8_LDA(At, 0, 1); PG8_STAGE(PG8_SA(0, 0), a2, voffA);
            PG8_BAR; PG8_WAIT_L(0); PG8_MMA(1, 0, At, B0); PG8_BAR; PG8_SCHED;
            PG8_STAGE(PG8_SB(0, 1), b2 + hstepB, voffB);
            PG8_WAIT_V(6); PG8_BAR; PG8_MMA(1, 1, At, B1); PG8_BAR;
            PG8_LDB(B0, 1, 0); PG8_SCHED; PG8_LDA(At, 1, 0); PG8_STAGE(PG8_SA(0, 1), a2 + hstepA, voffA);
            PG8_WAIT_L(8); PG8_BAR; PG8_WAIT_L(0); PG8_MMA(0, 0, At, B0); PG8_BAR; PG8_SCHED;
            PG8_LDB(B1, 1, 1); PG8_STAGE(PG8_SB(1, 0), b3, voffB);
            PG8_BAR; PG8_WAIT_L(0); PG8_MMA(0, 1, At, B1); PG8_BAR;
            PG8_LDA(At, 1, 1); PG8_STAGE(PG8_SA(1, 0), a3, voffA);
            PG8_BAR; PG8_WAIT_L(0); PG8_MMA(1, 0, At, B0); PG8_BAR; PG8_SCHED;
            PG8_STAGE(PG8_SB(1, 1), b3 + hstepB, voffB);
            PG8_WAIT_V(6); PG8_BAR; PG8_MMA(1, 1, At, B1); PG8_BAR;
            }
        }
        if constexpr (ALIGN_EPI) { if (wr == 0) PG8_BAR; }
        if constexpr (!Epi::AFTER_DRAIN) { E(acc, cur, wr, wc, fr, fq); S.done(cur); }
        if (!has_next) break;
#pragma unroll
        for (int a = 0; a < 2; ++a)
#pragma unroll
            for (int b = 0; b < 2; ++b)
#pragma unroll
                for (int m = 0; m < 4; ++m)
#pragma unroll
                    for (int n = 0; n < 2; ++n) acc[a][b][m][n] = (f32x4){0.f, 0.f, 0.f, 0.f};
        cur = nxt; cA = nA; cB = nB; ++ui;
        if constexpr (ALIGN_EPI) { if (wr == 1) PG8_BAR; }
    }
    PG8_WAIT_V(0);
    if constexpr (!ALIGN_EPI) { if (wr == 0) PG8_BAR; }
    PG8_BAR;
    if constexpr (Epi::AFTER_DRAIN) { E.fused(acc, cur, wr, wc, fr, fq, lds, wid, lane); S.done(cur); }
#undef PG8_SA
#undef PG8_SB
#undef PG8_STAGE
#undef PG8_LDA
#undef PG8_LDB
#undef PG8_MMA
#undef PG8_WAIT_V
#undef PG8_WAIT_L
#undef PG8_BAR
#undef PG8_SCHED
}
}
#include <hip/hip_bf16.h>
#include <cmath>
namespace attn_body {
using bf16=__hip_bfloat16;
using bf16x8=__attribute__((ext_vector_type(8)))short;
using s16x4=__attribute__((ext_vector_type(4)))short;
using f32x16=__attribute__((ext_vector_type(16)))float;
using u32x4=__attribute__((ext_vector_type(4)))unsigned;
using f32x4b=__attribute__((ext_vector_type(4)))float;
constexpr int BATCH=2,NHEAD=16,SEQ=16384,D=64,DM=NHEAD*D;
constexpr int NW=8,QBLK=32,QB=QBLK*NW,KVBLK=64,NQB=SEQ/QB;
constexpr int ATTN_PITCH=DM, ATTN_UNIT_ROWS=QB;
__device__ __forceinline__ int crow(int r,int hi){return (r&3)+8*(r>>2)+4*hi;}
#define SBAR() __builtin_amdgcn_sched_barrier(0)
__device__ __forceinline__ void cmask(f32x16&p0,f32x16&p1,int jb,int qrel,int hi){
  const float NEG=-INFINITY; int kb=64*jb+4*hi;
  #pragma unroll
  for(int r=0;r<16;++r){int kv=kb+(r&3)+8*(r>>2); if(kv>qrel)p0[r]=NEG; if(kv+32>qrel)p1[r]=NEG;}
}

constexpr int NSLOT=3, SLOTB=8192;
constexpr int LDS_K=0, LDS_V=NSLOT*SLOTB, LDS_WS=2*NSLOT*SLOTB, LDS_OST=LDS_WS+NW*64*4, LDS_KB=LDS_OST+NW*4096, LDS_BYTES=LDS_KB+SEQ*4+64;
constexpr float C2=0.125f*1.4426950408889634f;
__device__ __forceinline__ void glds16(const void*gsrc,unsigned lds_dst){unsigned keep;
  asm volatile("s_mov_b32 %0, m0\n\ts_mov_b32 m0, %2\n\ts_nop 0\n\tglobal_load_lds_dwordx4 %1, off\n\ts_mov_b32 m0, %0":"=&s"(keep):"v"(gsrc),"s"(lds_dst):"memory");}
__device__ __forceinline__ float max3f(float a,float b,float c){float r;asm("v_max3_f32 %0, %1, %2, %3":"=v"(r):"v"(a),"v"(b),"v"(c));return r;}
__device__ __forceinline__ float max2f(float a,float b){float r;asm("v_max_f32_e32 %0, %1, %2":"=v"(r):"v"(a),"v"(b));return r;}
__device__ __forceinline__ float fadd_s(float a,float b){float r;asm("v_add_f32_e32 %0, %1, %2":"=v"(r):"v"(a),"v"(b));return r;}
__device__ __forceinline__ float fsub_s(float a,float b){float r;asm("v_sub_f32_e32 %0, %1, %2":"=v"(r):"v"(a),"v"(b));return r;}
typedef float f32x2_t __attribute__((ext_vector_type(2))); typedef __bf16 bf16x2_t __attribute__((ext_vector_type(2)));
__device__ __forceinline__ unsigned cvtpk_s(float lo,float hi){f32x2_t v={lo,hi};bf16x2_t b=__builtin_convertvector(v,bf16x2_t);return __builtin_bit_cast(unsigned,b);}
#define WAIT_BAR(N) asm volatile("s_waitcnt vmcnt(" #N ") lgkmcnt(0)\n\ts_barrier":::"memory")

typedef short s16x4b __attribute__((ext_vector_type(4))); typedef unsigned u32x2b __attribute__((ext_vector_type(2)));
#define BIAS_MFMA(a0_,d1_,qm_) __builtin_amdgcn_mfma_f32_32x32x8bf16_1k(__builtin_bit_cast(s16x4b,(u32x2b){(a0_),(d1_)}),__builtin_bit_cast(s16x4b,(qm_)),f32x16{},0,0,0)
__device__ __forceinline__ void qkt(f32x16&p0,f32x16&p1,const char*Kslot,const bf16x8*qr,unsigned ka0,unsigned ka1,unsigned kd1,u32x2b qm,int r32,int hi){
  p0=BIAS_MFMA(ka0,kd1,qm); p1=BIAS_MFMA(ka1,kd1,qm);
  const char*kb=Kslot+hi*1024+r32*16;
  #pragma unroll
  for(int d0=0;d0<4;++d0){
    const bf16x8 b0=*reinterpret_cast<const bf16x8*>(kb+d0*2048);
    const bf16x8 b1=*reinterpret_cast<const bf16x8*>(kb+d0*2048+512);
    {p0=__builtin_amdgcn_mfma_f32_32x32x16_bf16(b0,qr[d0],p0,0,0,0);p1=__builtin_amdgcn_mfma_f32_32x32x16_bf16(b1,qr[d0],p1,0,0,0);}}
}
typedef __attribute__((address_space(3))) const char* lds_cptr;
typedef short v4i16_t __attribute__((ext_vector_type(4)));
__device__ __forceinline__ void kload8(bf16x8*kf,lds_cptr kp){
  kf[0]=*(const __attribute__((address_space(3))) bf16x8*)(kp);      kf[1]=*(const __attribute__((address_space(3))) bf16x8*)(kp+512);
  kf[2]=*(const __attribute__((address_space(3))) bf16x8*)(kp+2048); kf[3]=*(const __attribute__((address_space(3))) bf16x8*)(kp+2560);
  kf[4]=*(const __attribute__((address_space(3))) bf16x8*)(kp+4096); kf[5]=*(const __attribute__((address_space(3))) bf16x8*)(kp+4608);
  kf[6]=*(const __attribute__((address_space(3))) bf16x8*)(kp+6144); kf[7]=*(const __attribute__((address_space(3))) bf16x8*)(kp+6656);
}
__device__ __forceinline__ void kload2(bf16x8*kf,lds_cptr kp,int j){ kf[2*j]=*(const __attribute__((address_space(3))) bf16x8*)(kp+j*2048); kf[2*j+1]=*(const __attribute__((address_space(3))) bf16x8*)(kp+j*2048+512); }
__device__ __forceinline__ s16x4 vtr(lds_cptr p){ return __builtin_bit_cast(s16x4,__builtin_amdgcn_ds_read_tr16_b64_v4i16((__attribute__((address_space(3))) v4i16_t*)p)); }
__device__ __forceinline__ float rowmax(const f32x16&p0,const f32x16&p1){
  float a=max3f(p0[0],p0[1],p1[0]),b=max3f(p0[2],p0[3],p1[1]);a=max3f(a,p1[2],p1[3]);
  #pragma unroll
  for(int r=4;r<16;r+=4){a=max3f(a,p0[r],p0[r+1]);b=max3f(b,p0[r+2],p0[r+3]);a=max3f(a,p1[r],p1[r+1]);b=max3f(b,p1[r+2],p1[r+3]);}
  const float m=max2f(a,b);
  auto rr=__builtin_amdgcn_permlane32_swap(__float_as_uint(m),__float_as_uint(m),false,false);
  return max2f(__uint_as_float(rr[0]),__uint_as_float(rr[1]));
}
__device__ __forceinline__ void pv(f32x16*o,int vb,bf16x8 pa0,bf16x8 pa1,bf16x8 pa2,bf16x8 pa3){
  #pragma unroll
  for(int d0=0;d0<2;++d0){s16x4 lo[4],hi[4];
    #pragma unroll
    for(int ks=0;ks<4;++ks){
      asm volatile("ds_read_b64_tr_b16 %0,%1 offset:%c2":"=&v"(lo[ks]):"v"(vb),"i"(d0*4096+ks*1024):"memory");
      asm volatile("ds_read_b64_tr_b16 %0,%1 offset:%c2":"=&v"(hi[ks]):"v"(vb),"i"(d0*4096+ks*1024+512):"memory");}
    asm volatile("s_waitcnt lgkmcnt(0)":::"memory");SBAR();
    #define PK(k) (bf16x8){lo[k][0],lo[k][1],lo[k][2],lo[k][3],hi[k][0],hi[k][1],hi[k][2],hi[k][3]}
    o[d0]=__builtin_amdgcn_mfma_f32_32x32x16_bf16(pa0,PK(0),o[d0],0,0,0);
    o[d0]=__builtin_amdgcn_mfma_f32_32x32x16_bf16(pa1,PK(1),o[d0],0,0,0);
    o[d0]=__builtin_amdgcn_mfma_f32_32x32x16_bf16(pa2,PK(2),o[d0],0,0,0);
    o[d0]=__builtin_amdgcn_mfma_f32_32x32x16_bf16(pa3,PK(3),o[d0],0,0,0);
    #undef PK
  }
}

#ifndef ATTN_STORE16
#define ATTN_STORE16(p,v) (*(u32x4*)(p)=(v))
#endif
template<int THRL> __device__ __forceinline__ void attn_unit(int b,int h,int qb,const bf16*Q,const bf16*__restrict__ K,const bf16*__restrict__ V,bf16*O,const float*__restrict__ CB,const float kmax,char*shm){
  int tid_=threadIdx.x; asm volatile("":"+v"(tid_)); const int tid=tid_,lane=tid&63,r32=lane&31,hi=lane>>5; const int wid=__builtin_amdgcn_readfirstlane(tid>>6);
  const long rowbase=(long)b*SEQ; const int q0=qb*QB;
  const bf16*Qw=Q+(rowbase+q0+wid*QBLK)*DM+h*D;
  const lds_cptr shm3=(lds_cptr)shm;
  const float*CBh=CB+((long)b*NHEAD+h)*SEQ;
  bf16x8 qr[4];
  #pragma unroll
  for(int d0=0;d0<4;++d0)qr[d0]=*reinterpret_cast<const bf16x8*>(&Qw[(long)r32*DM+d0*16+hi*8]);
  const int NTfull=(q0+QB)/KVBLK;
  const float cref=CBh[q0];
  const int t0c=2*(tid+1); const bool cand=t0c<=NTfull-4; const float cvc=cand?CBh[64*t0c-1]:0.f;
  const float mrow=cref-CBh[q0+wid*QBLK+r32];
  __attribute__((address_space(3))) unsigned*t0slot=(__attribute__((address_space(3))) unsigned*)(shm3+LDS_KB+SEQ*4);
  { float qa=0.f;
    #pragma unroll
    for(int d0=0;d0<4;++d0)
      #pragma unroll
      for(int e=0;e<8;++e){const float qv=__uint_as_float((unsigned)(unsigned short)qr[d0][e]<<16);qa+=qv*qv;}
    qa+=__shfl_xor(qa,32);
    #pragma unroll
    for(int of=1;of<32;of<<=1)qa=__builtin_fmaxf(qa,__shfl_xor(qa,of));
    if(lane==0)*(__attribute__((address_space(3))) float*)(shm3+LDS_WS+wid*256)=qa;
    if(tid==0)*t0slot=0u;
    asm volatile("s_waitcnt lgkmcnt(0)\n\ts_barrier":::"memory");
    float qmax=0.f;
    #pragma unroll
    for(int w=0;w<NW;++w)qmax=__builtin_fmaxf(qmax,*(const __attribute__((address_space(3))) float*)(shm3+LDS_WS+w*256));
    const float qkb=__builtin_sqrtf(qmax)*kmax*1.0005f+1.0f;
    const bool pass=cand&&((cref-cvc)+qkb<-127.0f);
    const unsigned long long bal=__ballot(pass);
    if(lane==0&&bal!=0ull)__hip_atomic_fetch_max(t0slot,(unsigned)(2*(wid*64+(63-__builtin_clzll(bal))+1)),__ATOMIC_RELAXED,__HIP_MEMORY_SCOPE_WORKGROUP);
    asm volatile("s_waitcnt lgkmcnt(0)\n\ts_barrier":::"memory"); }
  const int t0=__builtin_amdgcn_readfirstlane((int)*t0slot);
  const int q0s=q0-t0*KVBLK;
  const bf16*Kh=K+(rowbase+t0*KVBLK)*DM+h*D,*Vh=V+(rowbase+t0*KVBLK)*DM+h*D;
  const unsigned lds0=(unsigned)(uintptr_t)shm;
  float*wsf=(float*)(shm+LDS_WS)+wid*64;
  const bf16*ksrc=Kh+(long)lane*DM+wid*8;
  const bf16*vsrc=Vh+(long)(16*(wid&3)+(lane>>2))*DM+(wid>>2)*32+(lane&3)*8;
  const unsigned kdst=lds0+LDS_K+wid*1024, vdst=lds0+LDS_V+wid*1024;
  #define DMA_K(t,slot) glds16(ksrc+(long)(t)*KVBLK*DM,(unsigned)__builtin_amdgcn_readfirstlane(kdst+(slot)))
  #define DMA_V(t,slot) glds16(vsrc+(long)(t)*KVBLK*DM,(unsigned)__builtin_amdgcn_readfirstlane(vdst+(slot)))
  const int vb0=(int)(lds0+LDS_V)+((lane>>4)&1)*32+(lane&3)*8+(4*hi+((lane&15)>>2))*64;
  const char*Kbase=shm+LDS_K; bf16x8 kf[8];
  const lds_cptr kp0=shm3+LDS_K+hi*1024+r32*16; const lds_cptr vp0=shm3+LDS_V+((lane>>4)&1)*32+(lane&3)*8+(4*hi+((lane&15)>>2))*64;
  const int NT=(q0s+QB)/KVBLK;
  const lds_cptr kbp=shm3+LDS_KB+r32*4; constexpr unsigned kd1=0x0000BF80u;
  #define KBLD(t,A0,A1) do{ const unsigned x0_=*(const __attribute__((address_space(3))) unsigned*)(kbp+(t)*256), x1_=*(const __attribute__((address_space(3))) unsigned*)(kbp+(t)*256+128); A0=hi?0xBF80BF80u:x0_; A1=hi?0xBF80BF80u:x1_; }while(0)
  u32x2b qm; qm.x=hi?0u:0x3F803F80u; qm.y=0u;
  #define QMSET() do{ if(hi){ const unsigned b0_=__float_as_uint(mhat)&0xffff0000u; const float r1_=mhat-__uint_as_float(b0_); const unsigned b1_=__float_as_uint(r1_)&0xffff0000u; const float r2_=r1_-__uint_as_float(b1_); qm.x=(b0_>>16)|b1_; qm.y=__float_as_uint(r2_)>>16; } }while(0)
  unsigned ka0,ka1;
  DMA_K(0,0);DMA_V(0,0);DMA_K(1,SLOTB);
  { const float*CBs=CBh+t0*KVBLK; __attribute__((address_space(3))) unsigned*kbl=(__attribute__((address_space(3))) unsigned*)(shm3+LDS_KB);
    for(int s0=tid*4;s0<q0s+QB;s0+=NW*64*4){ const f32x4b cv=*(const f32x4b*)(CBs+s0); u32x4 w;
      _Pragma("unroll") for(int e=0;e<4;++e){ const float v=cref-cv[e]; const unsigned vb=__float_as_uint(v)&0xffff0000u; const float r=v-__uint_as_float(vb); w[e]=(vb>>16)|(__float_as_uint(r)&0xffff0000u); }
      *(__attribute__((address_space(3))) u32x4*)(kbl+s0)=w; }
 }
  float mhat=mrow,l_reg=0.f; QMSET();f32x16 o[2];o[0]=f32x16{};o[1]=f32x16{};
  const int qrel=wid*QBLK+r32;
  #define CMASK(P0,P1,t) do{int jb_=(t)-(NT-4); if(jb_>=0)cmask(P0,P1,jb_,qrel,hi);}while(0)
  bool resc=false;
  #define START(P0,P1) do{ const float rm=rowmax(P0,P1); resc=false; \
    { const float dl=__builtin_fmaxf(rm,0.f); mhat=fadd_s(mhat,dl); \
      _Pragma("unroll") for(int r=0;r<16;++r){P0[r]=fsub_s(P0[r],dl);P1[r]=fsub_s(P1[r],dl);} \
      QMSET(); } \
    _Pragma("unroll") for(int r=0;r<16;++r)P0[r]=__builtin_amdgcn_exp2f(P0[r]); }while(0)
  #define RESC() do{ if(resc){ asm volatile("s_waitcnt lgkmcnt(0)":::"memory"); \
      _Pragma("unroll") for(int d_=0;d_<2;++d_) _Pragma("unroll") for(int r=0;r<16;++r)o[d_][r]*=wsf[crow(r,hi)]; } }while(0)
  f32x16 pA0,pA1,pB0,pB1;
  int sl_prev=0,sl_cur=0,sl_next=SLOTB;
  #define ROT() do{sl_prev=sl_cur;sl_cur=sl_next;sl_next=(sl_next==(NSLOT-1)*SLOTB)?0:sl_next+SLOTB;}while(0)
  DMA_K(2,2*SLOTB);
  WAIT_BAR(3); KBLD(0,ka0,ka1);
  qkt(pA0,pA1,Kbase,qr,ka0,ka1,kd1,qm,r32,hi);asm volatile("s_nop 15\n\ts_nop 7":"+v"(pA0),"+v"(pA1));CMASK(pA0,pA1,0);
  START(pA0,pA1);
  _Pragma("unroll") for(int r=0;r<16;++r)pA1[r]=__builtin_amdgcn_exp2f(pA1[r]);
  WAIT_BAR(0);
  DMA_K(3,0);DMA_V(1,SLOTB);
  ROT();
  kload8(kf,kp0+sl_cur); KBLD(1,ka0,ka1);
  WAIT_BAR(2);
  s16x4 vlo[8],vhi[8]; u32x4 pw0,pw1,pw2,pw3;
  #define PKW(P,B) cvtpk_s(P[B],P[B+1])
  #define PAF(k) __builtin_bit_cast(bf16x8,pw##k)
  #define VFR(i) (bf16x8){vlo[i][0],vlo[i][1],vlo[i][2],vlo[i][3],vhi[i][0],vhi[i][1],vhi[i][2],vhi[i][3]}
  #define PIN(x) asm volatile("":"+v"(x))
  #define MX3(a,b,c) __builtin_fmaxf(__builtin_fmaxf((a),(b)),(c))
  #define GAPA(MF,A0,A1,A2,A3,W0,W1,PW) do{ MF; sacc+=A0; sacc+=A1; sacc+=A2; sacc+=A3; PIN(sacc); W0; W1; PIN(PW); SBAR(); }while(0)
  #define EX(v) __builtin_amdgcn_exp2f(v)
  #define GAPB(MF,X,B) do{ MF; X[B]=EX(X[B]); X[B+1]=EX(X[B+1]); X[B+2]=EX(X[B+2]); X[B+3]=EX(X[B+3]); PIN(X); SBAR(); }while(0)
  #define VRD(i) do{ vlo[i]=vtr(vp_+(((i)>>2)*4096+((i)&3)*1024)); vhi[i]=vtr(vp_+(((i)>>2)*4096+((i)&3)*1024+512)); }while(0)
  #define KRD(G,j) do{ if(G){ kload2(kf,kp0+sl_next,j); SBAR(); } }while(0)
  #define STEP(C0,C1,P0,P1,t,GK,GV,GL) do{ SBAR(); \
    const lds_cptr vp_=vp0+sl_prev; \
    VRD(0); SBAR(); float sacc=(P0[0]+P0[1]); \
    C0=BIAS_MFMA(ka0,kd1,qm); C1=BIAS_MFMA(ka1,kd1,qm); \
    GAPA(C0=__builtin_amdgcn_mfma_f32_32x32x16_bf16(kf[0],qr[0],C0,0,0,0), P0[2],P0[3],P0[4],P0[5],     pw0[0]=PKW(P0,0), pw0[1]=PKW(P0,2), pw0); \
    VRD(4); SBAR(); GAPA(C1=__builtin_amdgcn_mfma_f32_32x32x16_bf16(kf[1],qr[0],C1,0,0,0), P0[6],P0[7],P0[8],P0[9],     pw0[2]=PKW(P0,4), pw0[3]=PKW(P0,6), pw0); \
    VRD(1); SBAR(); GAPA(C0=__builtin_amdgcn_mfma_f32_32x32x16_bf16(kf[2],qr[1],C0,0,0,0),   P0[10],P0[11],P0[12],P0[13], pw1[0]=PKW(P0,8), pw1[1]=PKW(P0,10), pw1); \
    VRD(5); SBAR(); GAPA(C1=__builtin_amdgcn_mfma_f32_32x32x16_bf16(kf[3],qr[1],C1,0,0,0),   P0[14],P0[15],P1[0],P1[1],   pw1[2]=PKW(P0,12),pw1[3]=PKW(P0,14), pw1); \
    VRD(2); SBAR(); GAPA(C0=__builtin_amdgcn_mfma_f32_32x32x16_bf16(kf[4],qr[2],C0,0,0,0),   P1[2],P1[3],P1[4],P1[5],     pw2[0]=PKW(P1,0), pw2[1]=PKW(P1,2), pw2); \
    VRD(6); SBAR(); GAPA(C1=__builtin_amdgcn_mfma_f32_32x32x16_bf16(kf[5],qr[2],C1,0,0,0),   P1[6],P1[7],P1[8],P1[9],     pw2[2]=PKW(P1,4), pw2[3]=PKW(P1,6), pw2); \
    VRD(3); SBAR(); GAPA(C0=__builtin_amdgcn_mfma_f32_32x32x16_bf16(kf[6],qr[3],C0,0,0,0),   P1[10],P1[11],P1[12],P1[13], pw3[0]=PKW(P1,8), pw3[1]=PKW(P1,10), pw3); \
    VRD(7); SBAR(); GAPA(C1=__builtin_amdgcn_mfma_f32_32x32x16_bf16(kf[7],qr[3],C1,0,0,0),   P1[14],P1[15],0.f,0.f,       pw3[2]=PKW(P1,12),pw3[3]=PKW(P1,14), pw3); \
    l_reg+=sacc; \
    if(GK){DMA_K((t)+3,sl_cur);} if(GV){DMA_V((t)+1,sl_next);} \
    CMASK(C0,C1,t); \
    { float a=MX3(C0[0],C0[1],C1[0]),b=MX3(C0[2],C0[3],C1[1]); a=MX3(a,C1[2],C1[3]); \
      _Pragma("unroll") for(int r=4;r<16;r+=4){a=MX3(a,C0[r],C0[r+1]);b=MX3(b,C0[r+2],C0[r+3]);a=MX3(a,C1[r],C1[r+1]);b=MX3(b,C1[r+2],C1[r+3]);} \
      float rm=__builtin_fmaxf(a,b); { auto rr=__builtin_amdgcn_permlane32_swap(__float_as_uint(rm),__float_as_uint(rm),false,false); rm=__builtin_fmaxf(__uint_as_float(rr[0]),__uint_as_float(rr[1])); } \
      resc=false; \
      if(__builtin_expect(__any(rm>(float)THRL),0)){ const float dl=__builtin_fmaxf(rm,0.f); mhat+=dl; \
        _Pragma("unroll") for(int r=0;r<16;++r){C0[r]-=dl;C1[r]-=dl;} \
        QMSET(); \
        const float f=__builtin_amdgcn_exp2f(-dl); l_reg*=f; if(hi==0)wsf[r32]=f; resc=true; } } \
    SBAR(); \
    GAPB(o[0]=__builtin_amdgcn_mfma_f32_32x32x16_bf16(PAF(0),VFR(0),o[0],0,0,0), C0,0); \
    GAPB(o[1]=__builtin_amdgcn_mfma_f32_32x32x16_bf16(PAF(0),VFR(4),o[1],0,0,0), C0,4); \
    if(GL){KBLD((t)+1,ka0,ka1);} KRD(GL,0); GAPB(o[0]=__builtin_amdgcn_mfma_f32_32x32x16_bf16(PAF(1),VFR(1),o[0],0,0,0), C0,8); \
    KRD(GL,1); GAPB(o[1]=__builtin_amdgcn_mfma_f32_32x32x16_bf16(PAF(1),VFR(5),o[1],0,0,0), C0,12); \
    KRD(GL,2); GAPB(o[0]=__builtin_amdgcn_mfma_f32_32x32x16_bf16(PAF(2),VFR(2),o[0],0,0,0), C1,0); \
    KRD(GL,3); GAPB(o[1]=__builtin_amdgcn_mfma_f32_32x32x16_bf16(PAF(2),VFR(6),o[1],0,0,0), C1,4); \
    GAPB(o[0]=__builtin_amdgcn_mfma_f32_32x32x16_bf16(PAF(3),VFR(3),o[0],0,0,0), C1,8); \
    GAPB(o[1]=__builtin_amdgcn_mfma_f32_32x32x16_bf16(PAF(3),VFR(7),o[1],0,0,0), C1,12); \
    }while(0)
  int t=1;
  #undef CMASK
  #define CMASK(P0,P1,t) do{}while(0)
  for(;t+5<NT;t+=2){
    STEP(pB0,pB1,pA0,pA1,t,true,true,true);     WAIT_BAR(2); RESC(); ROT();
    STEP(pA0,pA1,pB0,pB1,t+1,true,true,true);   WAIT_BAR(2); RESC(); ROT();
  }
  #undef CMASK
  #define CMASK(P0,P1,t) do{int jb_=(t)-(NT-4); if(jb_>=0)cmask(P0,P1,jb_,qrel,hi);}while(0)
  #define ENDW(tt) do{ if((tt)+3<NT){WAIT_BAR(2);} else if((tt)+2<NT){WAIT_BAR(1);} else {WAIT_BAR(0);} }while(0)
  for(;t+1<NT;t+=2){
    STEP(pB0,pB1,pA0,pA1,t,(t+3<NT),(t+1<NT),(t+1<NT));       ENDW(t);   RESC(); ROT();
    STEP(pA0,pA1,pB0,pB1,t+1,(t+4<NT),(t+2<NT),(t+2<NT));     ENDW(t+1); RESC(); ROT();
  }
  STEP(pB0,pB1,pA0,pA1,NT-1,false,false,false); RESC();
  { float sacc=pB0[0]+pB0[1]; _Pragma("unroll") for(int r=2;r<16;++r)sacc+=pB0[r]; _Pragma("unroll") for(int r=0;r<16;++r)sacc+=pB1[r]; l_reg+=sacc;
    pw0=(u32x4){PKW(pB0,0),PKW(pB0,2),PKW(pB0,4),PKW(pB0,6)};pw1=(u32x4){PKW(pB0,8),PKW(pB0,10),PKW(pB0,12),PKW(pB0,14)};pw2=(u32x4){PKW(pB1,0),PKW(pB1,2),PKW(pB1,4),PKW(pB1,6)};pw3=(u32x4){PKW(pB1,8),PKW(pB1,10),PKW(pB1,12),PKW(pB1,14)};
    SBAR(); pv(o,vb0+sl_cur,PAF(0),PAF(1),PAF(2),PAF(3)); }
  #undef PKW
  #undef PAF
  #undef VFR
  #undef PIN
  #undef MX3
  #undef GAPA
  #undef GAPB
  #undef EX
  #undef VRD
  #undef KRD
  #undef STEP
  #undef ENDW
  {auto rr=__builtin_amdgcn_permlane32_swap(__float_as_uint(l_reg),__float_as_uint(l_reg),false,false);l_reg=__uint_as_float(rr[0])+__uint_as_float(rr[1]);}
  if(hi==0)wsf[32+r32]=l_reg;asm volatile("s_waitcnt lgkmcnt(0)":::"memory");
  float rli[16];
  #pragma unroll
  for(int r=0;r<16;++r)rli[r]=__builtin_amdgcn_rcpf(wsf[32+crow(r,hi)]);
  bf16*Ow=O+(rowbase+q0+wid*QBLK)*DM+h*D;
  { bf16*stg=(bf16*)(shm+LDS_OST)+wid*2048;
    #pragma unroll
    for(int r=0;r<16;++r){const int orow=crow(r,hi);
      #pragma unroll
      for(int d0=0;d0<2;++d0)stg[orow*64+d0*32+r32]=__float2bfloat16(o[d0][r]*rli[r]);}
    asm volatile("s_waitcnt lgkmcnt(0)":::"memory");
    #pragma unroll
    for(int i=0;i<4;++i){const int row=i*8+(lane>>3),ch=lane&7; const u32x4 v=*(const u32x4*)(stg+row*64+ch*8); ATTN_STORE16(Ow+(long)row*DM+ch*8,v);} }
  asm volatile("s_waitcnt lgkmcnt(0)\n\ts_barrier":::"memory");
  #undef DMA_K
  #undef KBLD
  #undef QMSET
  #undef DMA_V
  #undef CMASK
  #undef START
  #undef RESC
  #undef ROT
}
constexpr int ATTN_LDS_BYTES=LDS_BYTES;
struct AttnTensors { const bf16* Q; const bf16* K; const bf16* V; bf16* O; const float* CB; };
struct AttnUnit { int bh; int qb; };
struct StaticOrder {
  int vcu;
  __device__ __forceinline__ explicit StaticOrder(int grid,int block):vcu((block%8)*(grid/8)+block/8){}
  __device__ __forceinline__ bool next(int i,AttnUnit&u)const{ if(i>=8)return false; const int s=vcu&7; u.bh=vcu>>3; const int j=7-i; u.qb=(j&1)?(16*(j>>1)+15-s):(16*(j>>1)+s); return true; }
  __device__ __forceinline__ void a_ready(const AttnUnit&)const{}
  __device__ __forceinline__ void done(const AttnUnit&)const{}
};
template<int THRL=8> __device__ __forceinline__ void attn_phase_dyn(char*lds,const AttnTensors&T,unsigned*qcnt,const unsigned*kmaxbits){
  const lds_cptr l3=(lds_cptr)lds; __attribute__((address_space(3))) int*uslot=(__attribute__((address_space(3))) int*)(l3+LDS_KB+SEQ*4+16);
  const unsigned x=(unsigned)__builtin_amdgcn_s_getreg((3<<11)|20)&7u;
  for(int it=0;;++it){
    if(threadIdx.x==0){ int u=-1;
      for(unsigned k=0;k<8u;++k){ const unsigned q=(x+k)&7u; const unsigned idx=__hip_atomic_fetch_add(qcnt+64*q,1u,__ATOMIC_RELAXED,__HIP_MEMORY_SCOPE_AGENT); if(idx<256u){u=(int)(q*256u+idx);break;} }
      uslot[it&1]=u; }
    asm volatile("s_waitcnt vmcnt(0) lgkmcnt(0)\n\ts_barrier":::"memory");
    const int u=__builtin_amdgcn_readfirstlane(uslot[it&1]);
    if(u<0)break;
    const int q=u>>8,idx=u&255,bh=4*q+(idx&3),qb=63-(idx>>2);
    attn_unit<THRL>(bh/NHEAD,bh%NHEAD,qb,T.Q,T.K,T.V,T.O,T.CB,__builtin_sqrtf(__uint_as_float(kmaxbits[2*bh])+__uint_as_float(kmaxbits[2*bh+1])),lds);
  }
}
template<class Sched,int THRL=8> __device__ __forceinline__ void attn_phase(char*lds,const AttnTensors&T,const Sched&S){
  AttnUnit u;
  for(int i=0;S.next(i,u);++i){ S.a_ready(u); attn_unit<THRL>(u.bh/NHEAD,u.bh%NHEAD,u.qb,T.Q,T.K,T.V,T.O,T.CB,1e30f,lds); S.done(u); }
}
#undef SBAR
#undef WAIT_BAR
}
constexpr int NWAVES = 8, NTHREADS = 512;
constexpr int BATCH = 2, SEQ = 16384, D = 1024, M = BATCH * SEQ, NH = 16, FFH = 2816, SGW = 2048, QKVN = 3088;
constexpr float LOG2E = 1.4426950408889634f;
constexpr size_t MiB = 1u << 20;
constexpr size_t WS_W = 0, WS_WSTRIDE = 32 * MiB;
constexpr size_t WS_XB = 128 * MiB;
constexpr size_t WS_BIG = 192 * MiB;
constexpr size_t WS_WA = 0;
constexpr size_t WS_WB = 8 * MiB;
constexpr size_t WS_WF1 = 12 * MiB;
constexpr size_t WS_WF2 = 23 * MiB;
constexpr size_t WS_WS = 28 * MiB + 524288;
constexpr size_t WS_SSQ = 478 * MiB;
constexpr size_t WS_LNP = 480 * MiB;
constexpr size_t WS_LF = 488 * MiB;
constexpr size_t WS_CB = 490 * MiB;
constexpr size_t WS_CTL = 492 * MiB;
constexpr size_t WS_BAR = 492 * MiB + 65536;
constexpr size_t WS_END = 493 * MiB;
constexpr int LDS_BYTES = 153600;
static_assert(attn_body::ATTN_LDS_BYTES <= LDS_BYTES && pg8::STAGE_BYTES + 20 * 1024 <= LDS_BYTES - 64, "LDS map");

#define GAS __attribute__((address_space(1)))
#define LAS __attribute__((address_space(3)))
typedef unsigned short bf16;
typedef unsigned v4u __attribute__((ext_vector_type(4)));
typedef unsigned v2u __attribute__((ext_vector_type(2)));
typedef float f32x4 __attribute__((ext_vector_type(4)));
typedef float f32x2 __attribute__((ext_vector_type(2)));
typedef short bf16x8 __attribute__((ext_vector_type(8)));
typedef float f32x16 __attribute__((ext_vector_type(16)));
#define LDS_WAIT() asm volatile("s_waitcnt lgkmcnt(0)" ::: "memory")
__device__ __forceinline__ unsigned f2bf(float f) { unsigned u = __builtin_bit_cast(unsigned, f); return (u + 0x7fffu + ((u >> 16) & 1u)) >> 16; }
__device__ __forceinline__ unsigned pk2(float lo, float hi) { return f2bf(lo) | (f2bf(hi) << 16); }
__device__ __forceinline__ float bf2f(unsigned short b) { return __builtin_bit_cast(float, (unsigned)b << 16); }
__device__ __forceinline__ float wave_sum(float v) {
#pragma unroll
    for (int o = 1; o < 64; o <<= 1) v += __shfl_xor(v, o);
    return v;
}
__device__ __forceinline__ void transpose_item(const float* W, int ldw, int K, const float* nw, bf16* WT, int mode, LAS float* scr, int item, int nblk, int lane) {
    const int kb = item / nblk, nb = item % nblk, k0 = 64 * kb, n0 = 32 * nb;
    const int c0 = mode ? (((n0 & 255) >> 7) * FFH + (n0 >> 8) * 128 + (n0 & 127)) : n0;
    const int c = lane & 7;
    f32x4 w0 = (f32x4){1.f, 1.f, 1.f, 1.f}, w1 = w0; if (nw) { w0 = *(const f32x4*)(nw + k0 + 8 * c); w1 = *(const f32x4*)(nw + k0 + 8 * c + 4); }
    const float* rowp = W + (size_t)k0 * ldw + c0; const unsigned loff = (unsigned)((lane >> 5) * ldw + (lane & 31)); LAS float* sdst = scr + (lane >> 5) * 33 + (lane & 31);
    { float tv[32];
#pragma unroll
      for (int i = 0; i < 32; ++i) { tv[i] = rowp[loff]; rowp += 2 * ldw; }
#pragma unroll
      for (int i = 0; i < 32; ++i) sdst[2 * i * 33] = tv[i]; }
    LDS_WAIT(); asm volatile("" ::: "memory");
#pragma unroll
    for (int j = 0; j < 4; ++j) { const int n = (lane >> 3) + 8 * j; const LAS float* s = scr + (8 * c) * 33 + n;
        v4u o; o.x = pk2(s[0 * 33] * w0.x, s[1 * 33] * w0.y); o.y = pk2(s[2 * 33] * w0.z, s[3 * 33] * w0.w); o.z = pk2(s[4 * 33] * w1.x, s[5 * 33] * w1.y); o.w = pk2(s[6 * 33] * w1.z, s[7 * 33] * w1.w);
        *(GAS v4u*)(WT + (size_t)(n0 + n) * K + k0 + 8 * c) = o; }
    LDS_WAIT(); asm volatile("" ::: "memory");
}
typedef GAS unsigned gu32;
#define RLX_AGENT __ATOMIC_RELAXED, __HIP_MEMORY_SCOPE_AGENT
#define XB_TMO      128
#define XB_XCNT(j)  (256  + 64 * (j))
#define XB_XSUB(j)  (1280 + 64 * (j))
#define XB_XGEN(j)  (2304 + 64 * (j))
#define XB_TOP      3328
#define XB_TOPGEN   3392
#define XCD_BAR_WORDS 3456
#define XB_SPIN_CAP (1u << 18)

__device__ __forceinline__ unsigned xb_ld(unsigned* p)              { return __hip_atomic_load(p, __ATOMIC_RELAXED, __HIP_MEMORY_SCOPE_AGENT); }
__device__ __forceinline__ unsigned xb_add(unsigned* p, unsigned v) { return __hip_atomic_fetch_add(p, v, __ATOMIC_RELAXED, __HIP_MEMORY_SCOPE_AGENT); }
__device__ __forceinline__ unsigned xb_xcc_id() { return (unsigned)__builtin_amdgcn_s_getreg((3 << 11) | 20) & 0xFu; }
#define XB_SPIN(cond, bar) do { unsigned _sp = 0; while (cond) { __builtin_amdgcn_s_sleep(1); \
    if ((++_sp & 255u) == 0u) { if (xb_ld(&(bar)[XB_TMO])) break; if (_sp > XB_SPIN_CAP) { atomicAdd(&(bar)[XB_TMO], 1u); break; } } } } while (0)

struct XcdBarrier {
    unsigned* bar; unsigned x;
    volatile LAS unsigned* st;
};

__device__ __forceinline__ XcdBarrier xcd_barrier_post(unsigned* bar, volatile LAS unsigned* st) {
    XcdBarrier b; b.bar = bar; b.x = xb_xcc_id(); b.st = st;
    if (threadIdx.x == 0) (void)xb_add(&bar[XB_XCNT(b.x)], 1u);
    return b;
}
__device__ __forceinline__ void xcd_barrier_complete(unsigned* bar, unsigned x, unsigned& nloc, unsigned& nx) {
    const unsigned G = gridDim.x * gridDim.y * gridDim.z;
    unsigned sum, cnt, mine, sp = 0u;
    for (;;) {
        sum = 0u; cnt = 0u; mine = 0u;
#pragma unroll
        for (unsigned j = 0; j < 16; ++j) { const unsigned c = xb_ld(&bar[XB_XCNT(j)]); sum += c; cnt += (c > 0u) ? 1u : 0u; mine = (j == x) ? c : mine; }
        if (sum == G) break;
        __builtin_amdgcn_s_sleep(1);
        if ((++sp & 255u) == 0u) { if (xb_ld(&bar[XB_TMO])) break; if (sp > XB_SPIN_CAP) { atomicAdd(&bar[XB_TMO], 1u); break; } }
    }
    nloc = mine > 0u ? mine : 1u; nx = cnt > 0u ? cnt : 1u;
}

__device__ __forceinline__ void xcd_barrier(const XcdBarrier& b) {
    asm volatile("s_waitcnt vmcnt(0)" ::: "memory");
    __syncthreads();
    if (threadIdx.x == 0) {
        unsigned* bar = b.bar;
        __builtin_amdgcn_s_waitcnt(0);
        unsigned nloc = b.st[0], nx = b.st[1];
        if (nloc == 0u) { xcd_barrier_complete(bar, b.x, nloc, nx); b.st[0] = nloc; b.st[1] = nx; }
        const unsigned old = xb_add(&bar[XB_XSUB(b.x)], 1u);
        const unsigned gen = old / nloc;
        if (old + 1u == (gen + 1u) * nloc) {
            __builtin_amdgcn_fence(__ATOMIC_RELEASE, "agent");
            asm volatile("s_waitcnt vmcnt(0)" ::: "memory");
            const unsigned og = xb_add(&bar[XB_TOP], 1u);
            const unsigned tg = og / nx;
            if (og + 1u == (tg + 1u) * nx) xb_add(&bar[XB_TOPGEN], 1u);
            else XB_SPIN(xb_ld(&bar[XB_TOPGEN]) == tg, bar);
            __builtin_amdgcn_fence(__ATOMIC_ACQUIRE, "agent");
            xb_add(&bar[XB_XGEN(b.x)], 1u);
            asm volatile("s_waitcnt vmcnt(0)" ::: "memory");
        } else {
            XB_SPIN(xb_ld(&bar[XB_XGEN(b.x)]) == gen, bar);
            __builtin_amdgcn_fence(__ATOMIC_ACQUIRE, "agent");
            asm volatile("s_waitcnt vmcnt(0)" ::: "memory");
        }
    }
    __syncthreads();
}

struct Args { const float* in[15]; float* out; unsigned char* ws; };
typedef __attribute__((address_space(4))) const Args* KArgs;
#define KARGS() ({ KArgs p_ = (KArgs)__builtin_amdgcn_kernarg_segment_ptr(); asm volatile("" : "+s"(p_)); p_; })

__device__ __forceinline__ void convert_weights(KArgs ka, int L, LAS unsigned char* lds, int gw, int NGW, int wave, int lane, int it0, int itstep, bool items, bool tril) {
    const int j = L >> 1; const bool attn = (L & 1) == 0;
    LAS float* scr = (LAS float*)(lds + wave * 16384);
    Args a; _Pragma("unroll") for (int i_ = 0; i_ < 15; ++i_) a.in[i_] = ka->in[i_]; a.out = ka->out; a.ws = ka->ws; unsigned char* ws = a.ws + WS_W + (size_t)L * WS_WSTRIDE;
    const float* W0 = attn ? a.in[2] + (size_t)j * D * QKVN : a.in[5] + (size_t)j * D * 4096;  const int ld0 = attn ? QKVN : 4096, nb0 = attn ? 96 : 128;
    const float* W1 = attn ? a.in[4] + (size_t)j * D * D : a.in[10] + (size_t)j * SGW * D;     const int K1 = attn ? D : SGW;
    const float* W2 = a.in[12] + (size_t)L * D * 2 * FFH;
    const float* W3 = a.in[13] + (size_t)L * FFH * D;
    const int I0 = 16 * nb0, I1 = (K1 / 64) * 32, I2 = 16 * 176, I3 = 44 * 32, NI = I0 + I1 + I2 + I3;
    if (items) for (int it = it0; it < NI; it += itstep) {
        int r = it;
        if (r < I0) { transpose_item(W0, ld0, D, a.in[1] + L * D, (bf16*)(ws + WS_WA), 0, scr, r, nb0, lane); continue; } r -= I0;
        if (r < I1) { transpose_item(W1, D, K1, nullptr, (bf16*)(ws + WS_WB), 0, scr, r, 32, lane); continue; } r -= I1;
        if (r < I2) { transpose_item(W2, 2 * FFH, D, a.in[11] + L * D, (bf16*)(ws + WS_WF1), 1, scr, r, 176, lane); continue; } r -= I2;
        transpose_item(W3, D, FFH, nullptr, (bf16*)(ws + WS_WF2), 0, scr, r, 32, lane);
    }
    if (!attn && tril) {
        const float* Wsrc = a.in[8] + (size_t)j * 16 * 128 * 128; bf16* Wd = (bf16*)(ws + WS_WS);
        for (int i = (gw * 64 + lane) * 4; i < 16 * 128 * 128; i += NGW * 64 * 4) { const f32x4 v = *(const f32x4*)(Wsrc + i); const int t = (i >> 7) & 127, s = i & 127;
            v2u o; o.x = pk2(s <= t ? v[0] : 0.f, s + 1 <= t ? v[1] : 0.f); o.y = pk2(s + 2 <= t ? v[2] : 0.f, s + 3 <= t ? v[3] : 0.f); *(v2u*)(Wd + i) = o; }
    }
}
__device__ __forceinline__ float log_sigmoid_f(float z) { return z >= 0.f ? -log1pf(expf(-z)) : z - log1pf(expf(z)); }
__device__ __forceinline__ void attn_row_pass(KArgs ka, int L, bool first, LAS unsigned char* lds, int gw, int NGW, int tid, int lane) {
    Args a; _Pragma("unroll") for (int i_ = 0; i_ < 15; ++i_) a.in[i_] = ka->in[i_]; a.out = ka->out; a.ws = ka->ws; const int j = L >> 1; unsigned char* ws = a.ws;
    LAS float* wf = (LAS float*)lds;
    const float* Wg = a.in[2] + (size_t)j * D * QKVN + 3072; const float* nw = a.in[1] + L * D;
    for (int idx = tid; idx < D * 16; idx += NTHREADS) { const int k = idx >> 4, h = idx & 15; wf[(((k & 3) + 4 * (k >> 8)) * 64 + ((k & 255) >> 2)) * 20 + h] = nw[k] * Wg[(size_t)k * QKVN + h]; }
    __syncthreads();
    const float* xsrc = a.in[0];
    bf16* XB = (bf16*)(ws + WS_XB); float* ssq = (float*)(ws + WS_SSQ); float* LF = (float*)(ws + WS_LF);
    const float bfv = a.in[3][j * 16 + (lane >> 2)];
    f32x4 nf[4], nf2[4]; v2u nb[4], nb2[4];
#define ROW_LOAD(NF_, NB_, r_) do { if (first) { const GAS f32x4* xr_ = (const GAS f32x4*)(xsrc + (size_t)(r_) * D) + lane; _Pragma("unroll") for (int q_ = 0; q_ < 4; ++q_) NF_[q_] = xr_[64 * q_]; } \
                          else { const GAS v2u* xb_ = (const GAS v2u*)(XB + (size_t)(r_) * D) + lane; _Pragma("unroll") for (int q_ = 0; q_ < 4; ++q_) NB_[q_] = xb_[64 * q_]; } } while (0)
    if (gw < M) ROW_LOAD(nf, nb, gw);
    if (gw + NGW < M) ROW_LOAD(nf2, nb2, gw + NGW);
    for (int row = gw; row < M; row += NGW) {
        GAS v2u* xb = (GAS v2u*)(XB + (size_t)row * D) + lane;
        f32x4 v[4]; float s2 = 0.f;
        if (first) {
#pragma unroll
            for (int q = 0; q < 4; ++q) { const f32x4 t = nf[q]; v2u o; o.x = pk2(t.x, t.y); o.y = pk2(t.z, t.w); xb[64 * q] = o;
                v[q] = (f32x4){__builtin_bit_cast(float, o.x << 16), __builtin_bit_cast(float, o.x & 0xffff0000u), __builtin_bit_cast(float, o.y << 16), __builtin_bit_cast(float, o.y & 0xffff0000u)}; }
        } else {
#pragma unroll
            for (int q = 0; q < 4; ++q) { const v2u o = nb[q];
                v[q] = (f32x4){__builtin_bit_cast(float, o.x << 16), __builtin_bit_cast(float, o.x & 0xffff0000u), __builtin_bit_cast(float, o.y << 16), __builtin_bit_cast(float, o.y & 0xffff0000u)}; }
        }
#pragma unroll
        for (int q = 0; q < 4; ++q) { nf[q] = nf2[q]; nb[q] = nb2[q]; }
        if (row + 2 * NGW < M) ROW_LOAD(nf2, nb2, row + 2 * NGW);
#pragma unroll
        for (int q = 0; q < 4; ++q) s2 += (v[q].x * v[q].x + v[q].y * v[q].y) + (v[q].z * v[q].z + v[q].w * v[q].w);
        s2 = wave_sum(s2);
        const float rstd = 1.0f / sqrtf(s2 * (1.0f / D) + 1e-6f);
        if (first && lane < 16) ssq[(size_t)row * 16 + lane] = lane == 0 ? s2 : 0.f;
        float acc[16];
#pragma unroll
        for (int h = 0; h < 16; ++h) acc[h] = 0.f;
#pragma unroll
        for (int q = 0; q < 4; ++q)
#pragma unroll
            for (int e = 0; e < 4; ++e) { const float xv = v[q][e]; const LAS f32x4* wr = (const LAS f32x4*)(wf + ((e + 4 * q) * 64 + lane) * 20);
#pragma unroll
                for (int c = 0; c < 4; ++c) { const f32x4 w = wr[c]; acc[4 * c] += xv * w.x; acc[4 * c + 1] += xv * w.y; acc[4 * c + 2] += xv * w.z; acc[4 * c + 3] += xv * w.w; }
                if (e & 1) asm volatile("" ::: "memory"); }
#define TR_STEP(N, MASK) _Pragma("unroll") for (int i = 0; i < N; ++i) { const bool up = (lane & MASK) != 0; const float keep = up ? acc[i + N] : acc[i], send = up ? acc[i] : acc[i + N]; acc[i] = keep + __shfl_xor(send, MASK); }
        TR_STEP(8, 32) TR_STEP(4, 16) TR_STEP(2, 8) TR_STEP(1, 4)
#undef TR_STEP
        float tot = acc[0]; tot += __shfl_xor(tot, 2); tot += __shfl_xor(tot, 1);
        if ((lane & 3) == 0) { const int b = row / SEQ, t = row % SEQ, h = lane >> 2; LF[((size_t)b * NH + h) * SEQ + t] = log_sigmoid_f(rstd * tot + bfv); }
    }
#undef ROW_LOAD
    __syncthreads();
}
__device__ __forceinline__ void scan_part(const float* LF, float* CB, int bx, LAS unsigned char* lds, int tid) {
    LAS double* red = (LAS double*)lds;
    const int bh = bx >> 3, p = bx & 7, lane = tid & 63, wv = tid >> 6;
    const f32x4* src = (const f32x4*)(LF + (size_t)bh * SEQ);
    double pre = 0.0;
    for (int i = tid; i < 512 * p; i += NTHREADS) { const f32x4 v = src[i]; pre += ((double)v.x + (double)v.y) + ((double)v.z + (double)v.w); }
    const f32x4 v = src[512 * p + tid];
    const double s0 = (double)v.x, s1 = s0 + (double)v.y, s2 = s1 + (double)v.z, s3 = s2 + (double)v.w;
    double inc = s3;
#pragma unroll
    for (int o = 1; o < 64; o <<= 1) { const double t = __shfl_up(inc, o); if (lane >= o) inc += t; }
#pragma unroll
    for (int o = 1; o < 64; o <<= 1) pre += __shfl_xor(pre, o);
    if (lane == 63) red[wv] = inc; if (lane == 0) red[8 + wv] = pre;
    __syncthreads();
    double base = 0.0;
#pragma unroll
    for (int w = 0; w < 8; ++w) { base += red[8 + w]; if (w < wv) base += red[w]; }
    base += inc - s3;
    f32x4 o; o.x = (float)((base + s0) * 1.4426950408889634); o.y = (float)((base + s1) * 1.4426950408889634); o.z = (float)((base + s2) * 1.4426950408889634); o.w = (float)((base + s3) * 1.4426950408889634);
    *((f32x4*)(CB + (size_t)bh * SEQ) + 512 * p + tid) = o;
    __syncthreads();
}
constexpr int VT_PITCH = 136;
__device__ __forceinline__ void sgu_phase(KArgs ka, int j, int bx, int G, LAS unsigned char* lds, int tid, int wave, int lane) {
    unsigned char* ws = ka->ws; bf16* Z = (bf16*)(ws + WS_BIG); const float* lnp = (const float*)(ws + WS_LNP);
    const int g = bx & 15; const bf16* Wc = (const bf16*)(ws + WS_W + (size_t)(2 * j + 1) * WS_WSTRIDE + WS_WS) + (size_t)g * 128 * 128;
    LAS unsigned* VT = (LAS unsigned*)lds; LAS f32x2* stats = (LAS f32x2*)(lds + 36864);
    const int db = wave & 3, th = wave >> 2, l32 = lane & 31, hi = lane >> 5;
    const int NU = 256 * 16 / G;
    bf16x8 wfr[2][8]; float bias[2];
#pragma unroll
    for (int tt = 0; tt < 2; ++tt) { const int t = (2 * th + tt) * 32 + l32; bias[tt] = (ka->in[9] + ((size_t)j * 16 + g) * 128)[t];
#pragma unroll
        for (int ks = 0; ks < 8; ++ks) wfr[tt][ks] = *(const bf16x8*)(Wc + (size_t)t * 128 + ks * 16 + 8 * hi); }
    const int cch = tid & 15, rpb = tid >> 4;
    f32x4 lg0, lg1, lb0, lb1;
    { const float* lng = ka->in[6] + (size_t)j * SGW + g * 128 + 8 * cch; const float* lnb = ka->in[7] + (size_t)j * SGW + g * 128 + 8 * cch;
      lg0 = *(const f32x4*)lng; lg1 = *(const f32x4*)(lng + 4); lb0 = *(const f32x4*)lnb; lb1 = *(const f32x4*)(lnb + 4); }
    const int sr = tid >> 2, spart = tid & 3;
    v4u vr[2][2]; f32x4 lp[4]; v4u ur[2][2];
#define SGU_LOAD_LNP(c_) do { const f32x4* p_ = (const f32x4*)(lnp + ((size_t)((c_) * 128 + sr) * 32 + spart * 8) * 2); _Pragma("unroll") for (int i_ = 0; i_ < 4; ++i_) lp[i_] = p_[i_]; } while (0)
#define SGU_LOAD_V(c_) do { _Pragma("unroll") for (int i_ = 0; i_ < 2; ++i_) { const bf16* p_ = Z + (size_t)((c_) * 128 + 2 * (rpb + 32 * i_)) * 4096 + SGW + g * 128 + 8 * cch; vr[i_][0] = *(const v4u*)p_; vr[i_][1] = *(const v4u*)(p_ + 4096); } } while (0)
#define SGU_UPTR(c_, tt_) (Z + (size_t)((c_) * 128 + (2 * th + (tt_)) * 32 + l32) * 4096 + g * 128 + db * 32 + 8 * hi)
#define SGU_LOAD_U(c_) do { _Pragma("unroll") for (int tt_ = 0; tt_ < 2; ++tt_) _Pragma("unroll") for (int c2_ = 0; c2_ < 2; ++c2_) ur[tt_][c2_] = *(const v4u*)(SGU_UPTR(c_, tt_) + 16 * c2_); } while (0)
    int c = bx >> 4; const int cstep = G >> 4;
    SGU_LOAD_LNP(c); SGU_LOAD_V(c); SGU_LOAD_U(c);
    for (int it = 0; it < NU; ++it, c += cstep) {
        const bool more = it + 1 < NU; const int cn = more ? c + cstep : c;
        { float s1 = 0.f, s2 = 0.f;
#pragma unroll
          for (int i = 0; i < 4; ++i) { s1 += lp[i].x + lp[i].z; s2 += lp[i].y + lp[i].w; }
          s1 += __shfl_xor(s1, 1); s1 += __shfl_xor(s1, 2); s2 += __shfl_xor(s2, 1); s2 += __shfl_xor(s2, 2);
          const float mean = s1 * (1.0f / SGW), var = s2 * (1.0f / SGW) - mean * mean;
          if (spart == 0) stats[sr] = (f32x2){mean, 1.0f / sqrtf(var + 1e-5f)}; }
        if (more) SGU_LOAD_LNP(cn);
        __syncthreads();
#pragma unroll
        for (int i = 0; i < 2; ++i) { const int rp = rpb + 32 * i, s = 2 * rp; const f32x2 st0 = stats[s], st1 = stats[s + 1];
#pragma unroll
            for (int e = 0; e < 8; ++e) { const unsigned w0 = vr[i][0][e >> 1], w1 = vr[i][1][e >> 1];
                const float x0 = bf2f((unsigned short)((e & 1) ? (w0 >> 16) : (w0 & 0xffffu))), x1 = bf2f((unsigned short)((e & 1) ? (w1 >> 16) : (w1 & 0xffffu)));
                const float gg = e < 4 ? lg0[e & 3] : lg1[e & 3], bb = e < 4 ? lb0[e & 3] : lb1[e & 3];
                VT[(8 * cch + e) * 68 + 4 * ((rp >> 2) ^ (cch & 7)) + (rp & 3)] = pk2((x0 - st0.x) * st0.y * gg + bb, (x1 - st1.x) * st1.y * gg + bb); } }
        if (more) SGU_LOAD_V(cn);
        __syncthreads();
#pragma unroll
        for (int tt = 0; tt < 2; ++tt) { const int tb = 2 * th + tt; f32x16 acc = f32x16{};
            const int d = db * 32 + ((l32 & 0x13) | ((l32 & 4) << 1) | ((l32 & 8) >> 1)); const LAS unsigned* vrow = VT + d * 68;
#pragma unroll
            for (int ks = 0; ks < 8; ++ks) if (ks <= 2 * tb + 1) {
                const bf16x8 af = *(const LAS bf16x8*)(vrow + 4 * ((2 * ks + hi) ^ ((d >> 3) & 7)));
                acc = __builtin_amdgcn_mfma_f32_32x32x16_bf16(af, wfr[tt][ks], acc, 0, 0, 0); }
            bf16* urow = SGU_UPTR(c, tt);
#pragma unroll
            for (int c2 = 0; c2 < 2; ++c2) { const v4u uw = ur[tt][c2]; v4u o;
#pragma unroll
                for (int e = 0; e < 4; ++e) { const unsigned wv = uw[e]; const float ua = bf2f((unsigned short)(wv & 0xffffu)), ub = bf2f((unsigned short)(wv >> 16));
                    o[e] = pk2(ua * (acc[8 * c2 + 2 * e] + bias[tt]), ub * (acc[8 * c2 + 2 * e + 1] + bias[tt])); }
                *(v4u*)(urow + 16 * c2) = o; } }
        if (more) SGU_LOAD_U(cn);
    }
    __syncthreads();
#undef SGU_LOAD_LNP
#undef SGU_LOAD_V
#undef SGU_UPTR
#undef SGU_LOAD_U
}

__global__ void __launch_bounds__(NTHREADS, 2) fox_gmlp_fwd(Args a_unused) {
    extern __shared__ __attribute__((aligned(16))) unsigned char lds_raw[];
    cg::grid_group grid = cg::this_grid();
    LAS unsigned char* lds = (LAS unsigned char*)lds_raw;
    const int G = gridDim.x, bx = blockIdx.x, NGW = G * NWAVES;
    volatile LAS unsigned* MISC = (volatile LAS unsigned*)(lds + LDS_BYTES - 32);
    if (threadIdx.x < 2) MISC[threadIdx.x] = 0u;
    if (bx == 0) { unsigned* bw = (unsigned*)(KARGS()->ws + WS_BAR); for (int i = threadIdx.x; i < XCD_BAR_WORDS; i += NTHREADS) bw[i] = 0u; }
    __syncthreads();
    XcdBarrier bar; bar.bar = nullptr; bar.x = 0; bar.st = nullptr; bool posted = false;
#define GRID_SYNC() do { if (!posted) { grid.sync(); bar = xcd_barrier_post((unsigned*)(KARGS()->ws + WS_BAR), MISC); posted = true; } else xcd_barrier(bar); } while (0)
#define TIDS() int tid_ = threadIdx.x; asm volatile("" : "+v"(tid_)); const int tid = tid_, lane = tid & 63, wave = __builtin_amdgcn_readfirstlane(tid >> 6), gw = bx * NWAVES + wave; (void)lane; (void)gw
#pragma nounroll
    for (int L = 0; L < 4; ++L) {
        const bool attn = (L & 1) == 0; const int j = L >> 1;
#pragma nounroll
        for (int part = 0; part < 2; ++part) {
            pg8::Gemm gr;
#define WSP() (KARGS()->ws)
            if (part == 0) {
                if (attn) { TIDS();
                    if (L == 0) {
                        convert_weights(KARGS(), 0, lds, gw, NGW, wave, lane, gw, NGW, true, false);
#pragma nounroll
                        for (int LL = 1; LL < 4; LL += 2) convert_weights(KARGS(), LL, lds, gw, NGW, wave, lane, 0, 1, false, true);
                        __syncthreads(); }
                    if (bx == 0) { unsigned* ctl = (unsigned*)(KARGS()->ws + WS_CTL); ctl[tid] = 0u; ctl[tid + 512] = 0u; }
                    attn_row_pass(KARGS(), L, L == 0, lds, gw, NGW, tid, lane);
                    GRID_SYNC(); }
                if (attn) {
#ifndef NO_SCAN
                    if (G == 8 * BATCH * NH) { TIDS(); unsigned char* ws = WSP(); scan_part((const float*)(ws + WS_LF), (float*)(ws + WS_CB), bx, lds, tid); }
#endif
#ifndef NO_QKV
                    { unsigned char* ws = WSP(); pg8::Gemm g{(const bf16*)(ws + WS_XB), (const bf16*)(ws + WS_W + (size_t)L * WS_WSTRIDE + WS_WA), M, 3 * D, D, D}; pg8::StaticOrder S; S.init(M, 3 * D, G, bx);
                      pg8::rstd_table(lds, (const float*)(ws + WS_SSQ), S); pg8::EpiQKV E{(bf16*)(ws + WS_BIG), (size_t)M * D, (const LAS float*)(lds + pg8::RTAB_OFF), attn_body::C2, (unsigned*)(ws + WS_CTL)};
                      pg8::gemm_phase<pg8::EpiQKV, pg8::StaticOrder, true, true>(lds, g, S, E); }
#endif
                    GRID_SYNC();
#ifndef NO_ATTN
                    { unsigned char* ws = WSP(); bf16* BIG = (bf16*)(ws + WS_BIG); const attn_body::AttnTensors AT{(const attn_body::bf16*)BIG, (const attn_body::bf16*)(BIG + (size_t)M * D), (const attn_body::bf16*)(BIG + (size_t)2 * M * D), (attn_body::bf16*)BIG, (const float*)(ws + WS_CB)};
                      attn_body::attn_phase_dyn<8>((char*)lds_raw, AT, (unsigned*)(ws + WS_CTL) + 64, (const unsigned*)(ws + WS_CTL)); }
                    {
                        TIDS(); LAS int* cslot = (LAS int*)(lds + LDS_BYTES - 64); constexpr int NI1 = 2048 + 1024 + 2816 + 1408, NI2 = 1536 + 512 + 2816 + 1408; const int gbase = (L == 0) ? 0 : NI1 + NI2, NTOT = (L == 0) ? NI1 + NI2 : 2 * NI1 + NI2;
                        for (int itb = 0;; ++itb) {
                            __syncthreads();
                            if (tid == 0) cslot[itb & 1] = (int)__hip_atomic_fetch_add((unsigned*)(KARGS()->ws + WS_CTL) + 600, 1u, __ATOMIC_RELAXED, __HIP_MEMORY_SCOPE_AGENT);
                            __syncthreads();
                            const int gi = gbase + cslot[itb & 1] * 8 + wave; if (gi - wave >= NTOT) break;
                            if (gi < NTOT) { const int LL = gi < NI1 ? 1 : (gi < NI1 + NI2 ? 2 : 3), it = gi - (LL == 1 ? 0 : (LL == 2 ? NI1 : NI1 + NI2));
                                convert_weights(KARGS(), LL, lds, gw, NGW, wave, lane, it, 1 << 30, true, false); } }
                        __syncthreads(); }
#endif
                    GRID_SYNC();
                    gr = pg8::Gemm{nullptr, nullptr, M, D, D, D};
                } else {
#ifndef NO_GELU
                    { unsigned char* ws = WSP(); pg8::Gemm g{(const bf16*)(ws + WS_XB), (const bf16*)(ws + WS_W + (size_t)L * WS_WSTRIDE + WS_WA), M, 4096, D, D}; pg8::StaticOrder S; S.init(M, 4096, G, bx);
                      pg8::rstd_table(lds, (const float*)(ws + WS_SSQ), S); pg8::EpiGeluLN E{(bf16*)(ws + WS_BIG), (const LAS float*)(lds + pg8::RTAB_OFF), (float*)(ws + WS_LNP)};
                      pg8::gemm_phase<pg8::EpiGeluLN, pg8::StaticOrder, true, true>(lds, g, S, E); }
#endif
                    GRID_SYNC();
#ifndef NO_SGU
                    { TIDS(); sgu_phase(KARGS(), j, bx, G, lds, tid, wave, lane); }
#endif
                    GRID_SYNC();
                    gr = pg8::Gemm{nullptr, nullptr, M, D, SGW, 4096};
                }
            } else {
#ifndef NO_SWI
                { unsigned char* ws = WSP(); pg8::Gemm g{(const bf16*)(ws + WS_XB), (const bf16*)(ws + WS_W + (size_t)L * WS_WSTRIDE + WS_WF1), M, 2 * FFH, D, D}; pg8::StaticOrder S; S.init(M, 2 * FFH, G, bx);
                  pg8::rstd_table(lds, (const float*)(ws + WS_SSQ), S); pg8::EpiSwiGLU E{(bf16*)(ws + WS_BIG), (const LAS float*)(lds + pg8::RTAB_OFF), FFH};
                  pg8::gemm_phase<pg8::EpiSwiGLU, pg8::StaticOrder, true, true>(lds, g, S, E); }
#endif
                GRID_SYNC();
                gr = pg8::Gemm{nullptr, nullptr, M, D, FFH, FFH};
            }
#ifndef NO_RES
            { unsigned char* ws = WSP(); gr.A = (const bf16*)(ws + WS_BIG); gr.Bt = (const bf16*)(ws + WS_W + (size_t)L * WS_WSTRIDE + (part == 0 ? WS_WB : WS_WF2)); pg8::StaticOrder S; S.init(M, D, G, bx); pg8::EpiRes E{(bf16*)(ws + WS_XB), (float*)(ws + WS_SSQ)};
              pg8::gemm_phase<pg8::EpiRes, pg8::StaticOrder, true, true>(lds, gr, S, E); }
#endif
            GRID_SYNC();
        }
    }
    { TIDS(); const KArgs ka = KARGS(); Args a; _Pragma("unroll") for (int i_ = 0; i_ < 15; ++i_) a.in[i_] = ka->in[i_]; a.out = ka->out; a.ws = ka->ws; const float* fw = a.in[14]; const bf16* XBf = (const bf16*)(a.ws + WS_XB);
      f32x4 fwv[4]; v2u nx[4];
#pragma unroll
      for (int q = 0; q < 4; ++q) fwv[q] = *((const f32x4*)fw + lane + 64 * q);
      if (gw < M) { const GAS v2u* xr = (const GAS v2u*)(XBf + (size_t)gw * D) + lane;
#pragma unroll
        for (int q = 0; q < 4; ++q) nx[q] = xr[64 * q]; }
      for (int row = gw; row < M; row += NGW) { GAS f32x4* o = (GAS f32x4*)(a.out + (size_t)row * D) + lane;
        f32x4 v[4]; float s2 = 0.f;
#pragma unroll
        for (int q = 0; q < 4; ++q) { const v2u t = nx[q]; v[q] = (f32x4){__builtin_bit_cast(float, t.x << 16), __builtin_bit_cast(float, t.x & 0xffff0000u), __builtin_bit_cast(float, t.y << 16), __builtin_bit_cast(float, t.y & 0xffff0000u)}; s2 += (v[q].x * v[q].x + v[q].y * v[q].y) + (v[q].z * v[q].z + v[q].w * v[q].w); }
        if (row + NGW < M) { const GAS v2u* xr = (const GAS v2u*)(XBf + (size_t)(row + NGW) * D) + lane;
#pragma unroll
          for (int q = 0; q < 4; ++q) nx[q] = xr[64 * q]; }
        const float rstd = 1.0f / sqrtf(wave_sum(s2) * (1.0f / D) + 1e-6f);
#pragma unroll
        for (int q = 0; q < 4; ++q) o[64 * q] = v[q] * rstd * fwv[q]; } }
}

extern "C" void kernel_launch(void* const* d_in, const int* in_sizes, int n_in, void* d_out, int out_size, void* d_ws, size_t ws_size, hipStream_t stream) {
    static int grid = 0;
    if (grid == 0) {
        if (n_in != 15 || in_sizes[0] != M * D || out_size != M * D || ws_size < WS_END) { fprintf(stderr, "kernel_launch: unexpected shapes (n_in %d, in0 %d, out %d, ws %zu < %zu); nothing launched\n", n_in, n_in > 0 ? in_sizes[0] : -1, out_size, ws_size, (size_t)WS_END); grid = -1; return; }
        int dev = 0, cus = 0, per_cu = 0;
        hipGetDevice(&dev); hipDeviceGetAttribute(&cus, hipDeviceAttributeMultiprocessorCount, dev);
        if (hipFuncSetAttribute((const void*)fox_gmlp_fwd, hipFuncAttributeMaxDynamicSharedMemorySize, LDS_BYTES) != hipSuccess) { fprintf(stderr, "kernel_launch: hipFuncSetAttribute failed\n"); grid = -1; return; }
        hipOccupancyMaxActiveBlocksPerMultiprocessor(&per_cu, (const void*)fox_gmlp_fwd, NTHREADS, LDS_BYTES);
        (void)hipGetLastError();
        if (per_cu < 1 || cus != 256) { fprintf(stderr, "kernel_launch: needs 256 CUs with one resident workgroup each (cus %d, per_cu %d)\n", cus, per_cu); if (cus != 256 || per_cu < 1) { grid = -1; return; } }
        grid = cus;
    }
    if (grid < 0) return;
    Args a{};
    for (int i = 0; i < 15; ++i) a.in[i] = (const float*)d_in[i];
    a.out = (float*)d_out; a.ws = (unsigned char*)d_ws;
    void* args[] = {&a};
    const hipError_t e = hipLaunchCooperativeKernel((const void*)fox_gmlp_fwd, dim3(grid), dim3(NTHREADS), args, LDS_BYTES, stream);
    if (e != hipSuccess) fprintf(stderr, "kernel_launch: cooperative launch failed: %s (grid %d)\n", hipGetErrorString(e), grid);
}
```
